# Optimizing an MI355X kernel written in HIP

```python
import jax, jax.numpy as jnp
from jax import lax
import numpy as np

D_MODEL = 1024
BATCH = 4
SEQ = 8192
DEPTH = 2

N_MIXERS = 2
N_A = (DEPTH + 1) // 2
N_B = DEPTH // 2

M_HEADS = 8
M_QK_DIM = 64
M_V_DIM = D_MODEL // M_HEADS
M_CHUNK = 64
M_F_BIAS_LO = 3.0
M_F_BIAS_HI = 6.0
M_IN_WIDTH = 2 * M_HEADS * M_QK_DIM + 2 * D_MODEL + 4 * M_HEADS

DILATED_GROUPS = ((128, 1), (512, 4), (2048, 16))
N_GROUPS = len(DILATED_GROUPS)
A_HEADS = 8
A_HEAD_DIM = D_MODEL // A_HEADS
A_IN_WIDTH = N_GROUPS * 3 * A_HEADS * A_HEAD_DIM
ROPE_DIM = A_HEAD_DIM // 4
ROPE_THETA = 500000.0
NEG_INF = -1e30

FFN_HIDDEN = -(-(8 * D_MODEL) // (3 * 256)) * 256
PLE_DIM = 256
EPS = 1e-6

kernel_name = "hybrid_mlstm_dilated_attn_encoder"


def rms_norm(x, w):
    xf = x.astype(jnp.float32)
    y = xf * lax.rsqrt(jnp.mean(xf * xf, axis=-1, keepdims=True) + EPS)
    return (y * w.astype(jnp.float32)).astype(x.dtype)


def mlstm_chunkwise(q, k, v, ig, lf):
    B, S, H, Dk = q.shape
    Dv = v.shape[-1]
    L = M_CHUNK
    nc = S // L
    qc = q.reshape(B, nc, L, H, Dk)
    kc = k.reshape(B, nc, L, H, Dk)
    vc = v.reshape(B, nc, L, H, Dv)
    igc = ig.reshape(B, nc, L, H)
    b = jnp.cumsum(lf.reshape(B, nc, L, H), axis=2)
    g = b[:, :, -1]
    a = g[:, :, None, :] - b + igc
    a_max = jnp.max(a, axis=2)

    def step(carry, inp):
        C, n, m = carry
        k_c, v_c, a_c, amax_c, g_c = inp
        m_new = jnp.maximum(g_c + m, amax_c)
        decay = jnp.exp(g_c + m - m_new)
        kw = k_c * jnp.exp(a_c - m_new[:, None, :])[..., None]
        C_new = decay[..., None, None] * C + jnp.einsum('blhk,blhv->bhkv', kw, v_c)
        n_new = decay[..., None] * n + jnp.sum(kw, axis=1)
        return (C_new, n_new, m_new), (C, n, m)

    init = (jnp.zeros((B, H, Dk, Dv), jnp.float32), jnp.zeros((B, H, Dk), jnp.float32),
            jnp.zeros((B, H), jnp.float32))
    xs = (jnp.moveaxis(kc, 1, 0), jnp.moveaxis(vc, 1, 0), jnp.moveaxis(a, 1, 0),
          jnp.moveaxis(a_max, 1, 0), jnp.moveaxis(g, 1, 0))
    _, (C_prev, n_prev, m_prev) = lax.scan(step, init, xs)
    C_prev = jnp.moveaxis(C_prev, 0, 1)
    n_prev = jnp.moveaxis(n_prev, 0, 1)
    m_prev = jnp.moveaxis(m_prev, 0, 1)

    bT = jnp.swapaxes(b, 2, 3)
    igT = jnp.swapaxes(igc, 2, 3)
    D = bT[..., :, None] - bT[..., None, :] + igT[..., None, :]
    tril = jnp.tril(jnp.ones((L, L), dtype=bool))
    D = jnp.where(tril, D, -jnp.inf)
    inter_log = bT + m_prev[..., None]
    m_j = jnp.maximum(inter_log, jnp.max(D, axis=-1))
    Dw = jnp.exp(D - m_j[..., None])
    inter_w = jnp.exp(inter_log - m_j)
    Sm = jnp.einsum('bnlhk,bnshk->bnhls', qc, kc) * Dw
    num = (jnp.einsum('bnhls,bnshv->bnlhv', Sm, vc)
           + jnp.swapaxes(inter_w, 2, 3)[..., None] * jnp.einsum('bnlhk,bnhkv->bnlhv', qc, C_prev))
    den = jnp.sum(Sm, axis=-1) + inter_w * jnp.einsum('bnlhk,bnhk->bnhl', qc, n_prev)
    denom = jnp.maximum(jnp.abs(den), jnp.exp(-m_j))
    h = num / jnp.swapaxes(denom, 2, 3)[..., None]
    return h.reshape(B, S, H, Dv)


def mlstm_mixer(xn, w_in, gate_bias, head_norm, w_out):
    B, S, _ = xn.shape
    H, Dk, Dv = M_HEADS, M_QK_DIM, M_V_DIM
    f32 = jnp.float32
    proj = xn @ w_in
    q, k, v, o, gates = jnp.split(
        proj, [H * Dk, 2 * H * Dk, 2 * H * Dk + D_MODEL, 2 * H * Dk + 2 * D_MODEL], axis=-1)
    q = q.astype(f32).reshape(B, S, H, Dk) * (Dk ** -0.5)
    k = k.astype(f32).reshape(B, S, H, Dk)
    v = v.astype(f32).reshape(B, S, H, Dv)
    gates = (gates.astype(f32) + gate_bias.astype(f32)).reshape(B, S, 4, H)
    ig_f, ig_b = gates[:, :, 0], gates[:, :, 1]
    lf_f = jax.nn.log_sigmoid(gates[:, :, 2])
    lf_b = jax.nn.log_sigmoid(gates[:, :, 3])
    h_fwd = mlstm_chunkwise(q, k, v, ig_f, lf_f)
    flip = lambda t: jnp.flip(t, axis=1)
    h_bwd = flip(mlstm_chunkwise(flip(q), flip(k), flip(v), flip(ig_b), flip(lf_b)))
    h = h_fwd + h_bwd
    h = h * lax.rsqrt(jnp.mean(h * h, axis=-1, keepdims=True) + EPS) * head_norm.astype(f32)
    h = jax.nn.sigmoid(o.astype(f32)) * h.reshape(B, S, H * Dv)
    return h.astype(xn.dtype) @ w_out


def apply_partial_rope(x, cos, sin):
    half = ROPE_DIM // 2
    x1 = x[..., :half]
    x2 = x[..., half:ROPE_DIM]
    rot = jnp.concatenate([x1 * cos - x2 * sin, x2 * cos + x1 * sin], axis=-1).astype(x.dtype)
    return jnp.concatenate([rot, x[..., ROPE_DIM:]], axis=-1)


def dilated_window_attention(q, k, v, dilation, radius):
    B, S, H, Dh = q.shape
    blk = radius
    U = S // dilation
    nb = -(-U // blk)
    Up = nb * blk

    def to_sub(t, front, back):
        t = t.reshape(B, U, dilation, H, Dh)
        return jnp.pad(t, ((0, 0), (front, back), (0, 0), (0, 0), (0, 0)))

    qb = to_sub(q, 0, Up - U).reshape(B, nb, blk, dilation, H, Dh)
    kb = to_sub(k, blk, Up - U + blk).reshape(B, nb + 2, blk, dilation, H, Dh)
    vb = to_sub(v, blk, Up - U + blk).reshape(B, nb + 2, blk, dilation, H, Dh)
    scores = jnp.concatenate(
        [jnp.einsum('bnqrhd,bnkrhd->bnrhqk', qb, kb[:, s:s + nb]) for s in range(3)], axis=-1)
    scores = scores.astype(jnp.float32) * (Dh ** -0.5)
    n_idx = jnp.arange(nb)[:, None, None]
    a_idx = jnp.arange(blk)[None, :, None]
    c_idx = jnp.arange(3 * blk)[None, None, :]
    delta = c_idx - blk - a_idx
    key_u = n_idx * blk - blk + c_idx
    valid = (jnp.abs(delta) <= radius) & (key_u >= 0) & (key_u < U)
    scores = jnp.where(valid[None, :, None, None], scores, NEG_INF)
    lse = jax.nn.logsumexp(scores, axis=-1)
    probs = jnp.exp(scores - lse[..., None]).astype(v.dtype)
    out = jnp.einsum('bnrhqk,bnkrhd->bnqrhd', probs[..., :blk], vb[:, 0:nb])
    for s in range(1, 3):
        out = out + jnp.einsum('bnrhqk,bnkrhd->bnqrhd', probs[..., s * blk:(s + 1) * blk], vb[:, s:s + nb])
    out = out.reshape(B, Up, dilation, H, Dh)[:, :U].reshape(B, S, H, Dh)
    lse = jnp.transpose(lse, (0, 1, 4, 2, 3)).reshape(B, Up, dilation, H)[:, :U].reshape(B, S, H)
    return out, lse


def dilated_mixer(xn, cos, sin, w_in, w_out):
    B, S, _ = xn.shape
    proj = (xn @ w_in).reshape(B, S, N_GROUPS, 3, A_HEADS, A_HEAD_DIM)
    outs, lses = [], []
    for g, (window, dil) in enumerate(DILATED_GROUPS):
        q = apply_partial_rope(proj[:, :, g, 0], cos, sin)
        k = apply_partial_rope(proj[:, :, g, 1], cos, sin)
        o_g, l_g = dilated_window_attention(q, k, proj[:, :, g, 2], dil, window // 2 // dil)
        outs.append(o_g)
        lses.append(l_g)
    w = jax.nn.softmax(jnp.stack(lses, axis=0), axis=0)
    o = jnp.einsum('gbsh,gbshd->bshd', w, jnp.stack(outs, axis=0).astype(jnp.float32))
    return o.reshape(B, S, A_HEADS * A_HEAD_DIM).astype(xn.dtype) @ w_out


def swiglu(xn, w_gate, w_up, w_down):
    return (jax.nn.silu(xn @ w_gate) * (xn @ w_up)) @ w_down


def setup_inputs(seed: int = 0) -> dict:
    key = jax.random.key(seed)
    ks = jax.random.split(key, 24)
    f32 = jnp.float32
    nrm = lambda k, shape, scale: jax.random.normal(k, shape, f32) * scale
    x = nrm(ks[0], (BATCH, SEQ, D_MODEL), 1.0)
    p = nrm(ks[1], (DEPTH, BATCH, SEQ, PLE_DIM), 1.0)
    positions = (jnp.arange(SEQ, dtype=jnp.int32)[None, :]
                 + jax.random.randint(ks[2], (BATCH, 1), 0, 4096, dtype=jnp.int32))
    norm_mix = 1.0 + nrm(ks[3], (DEPTH, D_MODEL), 0.01)
    a_w_in = nrm(ks[4], (N_A, D_MODEL, M_IN_WIDTH), D_MODEL ** -0.5)
    ig_bias = nrm(ks[5], (N_A, 2 * M_HEADS), 0.1)
    fg_bias = (jnp.tile(jnp.linspace(M_F_BIAS_LO, M_F_BIAS_HI, M_HEADS, dtype=f32), (N_A, 2))
               + nrm(ks[6], (N_A, 2 * M_HEADS), 0.01))
    a_gate_bias = jnp.concatenate([ig_bias, fg_bias], axis=-1)
    a_head_norm = 1.0 + nrm(ks[7], (N_A, M_HEADS, M_V_DIM), 0.01)
    a_w_out = nrm(ks[8], (N_A, D_MODEL, D_MODEL), D_MODEL ** -0.5)
    b_w_in = nrm(ks[9], (N_B, D_MODEL, A_IN_WIDTH), D_MODEL ** -0.5)
    b_w_out = nrm(ks[10], (N_B, A_HEADS * A_HEAD_DIM, D_MODEL), (A_HEADS * A_HEAD_DIM) ** -0.5)
    norm_ffn = 1.0 + nrm(ks[11], (DEPTH, D_MODEL), 0.01)
    w_gate = nrm(ks[12], (DEPTH, D_MODEL, FFN_HIDDEN), D_MODEL ** -0.5)
    w_up = nrm(ks[13], (DEPTH, D_MODEL, FFN_HIDDEN), D_MODEL ** -0.5)
    w_down = nrm(ks[14], (DEPTH, FFN_HIDDEN, D_MODEL), FFN_HIDDEN ** -0.5)
    norm_ple = 1.0 + nrm(ks[15], (DEPTH, D_MODEL), 0.01)
    ple_gate = nrm(ks[16], (DEPTH, D_MODEL, D_MODEL), D_MODEL ** -0.5)
    ple_proj = nrm(ks[17], (DEPTH, PLE_DIM, D_MODEL), PLE_DIM ** -0.5)
    final_norm = 1.0 + nrm(ks[18], (D_MODEL,), 0.01)
    return {"x": x, "p": p, "positions": positions, "norm_mix": norm_mix,
            "a_w_in": a_w_in, "a_gate_bias": a_gate_bias, "a_head_norm": a_head_norm, "a_w_out": a_w_out,
            "b_w_in": b_w_in, "b_w_out": b_w_out, "norm_ffn": norm_ffn,
            "w_gate": w_gate, "w_up": w_up, "w_down": w_down,
            "norm_ple": norm_ple, "ple_gate": ple_gate, "ple_proj": ple_proj, "final_norm": final_norm}


def reference(x, p, positions, norm_mix, a_w_in, a_gate_bias, a_head_norm, a_w_out, b_w_in, b_w_out,
              norm_ffn, w_gate, w_up, w_down, norm_ple, ple_gate, ple_proj, final_norm):
    inv_freq = ROPE_THETA ** (-jnp.arange(0, ROPE_DIM, 2, dtype=jnp.float32) / ROPE_DIM)
    angles = positions.astype(jnp.float32)[..., None] * inv_freq
    cos = jnp.cos(angles)[:, :, None, :]
    sin = jnp.sin(angles)[:, :, None, :]
    h = x
    for i in range(DEPTH):
        j = i // N_MIXERS
        hn = rms_norm(h, norm_mix[i])
        if i % N_MIXERS == 0:
            mix = mlstm_mixer(hn, a_w_in[j], a_gate_bias[j], a_head_norm[j], a_w_out[j])
        else:
            mix = dilated_mixer(hn, cos, sin, b_w_in[j], b_w_out[j])
        h = h + mix
        h = h + swiglu(rms_norm(h, norm_ffn[i]), w_gate[i], w_up[i], w_down[i])
        gate = jax.nn.sigmoid(rms_norm(h, norm_ple[i]) @ ple_gate[i])
        h = h + gate * (p[i] @ ple_proj[i])
    return rms_norm(h, final_norm)
```

```cpp
#include <hip/hip_runtime.h>
#include <hip/hip_cooperative_groups.h>
#include <cstdio>
#include <cmath>
namespace cg = cooperative_groups;
#include <hip/hip_runtime.h>
namespace pg8 {
#define PG8_LAS __attribute__((address_space(3)))
typedef unsigned short bf16_t;
typedef short bf16x8 __attribute__((ext_vector_type(8)));
typedef float f32x4 __attribute__((ext_vector_type(4)));
typedef unsigned u32x4 __attribute__((ext_vector_type(4)));
constexpr int BM = 256, BK = 64, HALF = 128, HTB = HALF * BK * 2  , STAGE_BYTES = 8 * HTB, NXCD = 8, WGM = 4;

__host__ __device__ __forceinline__ int lds_byte(int r, int c) { const int st = (r >> 4) * 2 + (c >> 5), rr = r & 15, cc = c & 31, ob = rr * 64 + cc * 2; return st * 1024 + (ob ^ (((ob >> 9) & 1) << 5)); }
__host__ __device__ __forceinline__ void stage_rc(int b, int& R, int& C) { const int st = b / 1024, sb = b % 1024, swz = sb ^ (((sb >> 9) & 1) << 5); R = (st >> 1) * 16 + swz / 64; C = (st & 1) * 32 + (swz % 64) / 2; }
__host__ __device__ __forceinline__ int perm32(int rho) { const int n = rho >> 4, i = rho & 15; return 8 * (i >> 2) + 4 * n + (i & 3); }

struct Unit { int pm, pn; };
struct Gemm { const bf16_t* A; const bf16_t* Bt; int M, N, K; };

struct StaticOrder {
    int nM, nN, nwg, G, c;
    __host__ __device__ void init(int M, int N, int G_, int c_) { nM = M / BM; nN = N / BM; nwg = nM * nN; G = G_; c = c_; }
    __host__ __device__ bool next(int i, Unit& u) const {
        const long L = (long)i * G + c; if (L >= nwg) return false;
        int wgid = (int)L; { const int q = nwg / NXCD, r = nwg % NXCD, xcd = wgid % NXCD, off = wgid / NXCD; wgid = (xcd < r ? xcd * (q + 1) : r * (q + 1) + (xcd - r) * q) + off; }
        const int nig = WGM * nN, gid = wgid / nig, fm = gid * WGM, gsz = (nM - fm) < WGM ? (nM - fm) : WGM;
        u.pm = fm + ((wgid % nig) % gsz); u.pn = (wgid % nig) / gsz; return true;
    }
    __device__ __forceinline__ void a_ready(const Unit&) const {}
    __device__ __forceinline__ void done(const Unit&) const {}
};
__device__ __forceinline__ unsigned cvt_pk_bf16(float lo, float hi) { unsigned r; asm volatile("v_cvt_pk_bf16_f32 %0, %1, %2" : "=v"(r) : "v"(lo), "v"(hi)); return r; }
typedef float f32x2 __attribute__((ext_vector_type(2)));
template <class Epi, class Sched>
__device__ __forceinline__ void gemm_phase(PG8_LAS unsigned char* lds, const Gemm g, const Sched& S, const Epi& E) {
    int tid_ = threadIdx.x; asm volatile("" : "+v"(tid_));
    const int tid = tid_, wid = __builtin_amdgcn_readfirstlane(tid >> 6), lane = tid & 63, wr = wid >> 2, wc = wid & 3, fr = lane & 15, fq = lane >> 4;
    const int K = g.K, nt = K / BK;
    unsigned voffA[2], voffB[2];
#pragma unroll
    for (int i = 0; i < 2; ++i) { int R, C; stage_rc(tid * 16 + i * 8192, R, C); const int Rb = Epi::PERM ? ((R & ~31) + perm32(R & 31)) : R;
        voffA[i] = (unsigned)(R * K + C) * 2u; voffB[i] = (unsigned)(Rb * K + C) * 2u; }
    const size_t kstep = (size_t)(BK * 2);
    const size_t hstep = (size_t)HALF * K * 2;
    const size_t tstep = 2 * hstep;
    const unsigned ldsw = (unsigned)wid * 1024u;
    const int aoff = lds_byte(wr * 64 + fr, fq * 8), boff = lds_byte(wc * 32 + fr, fq * 8);
#define PG8_SA(b, h) (((b) * 2 + (h)) * HTB)
#define PG8_SB(b, h) ((4 + (b) * 2 + (h)) * HTB)
#define PG8_STAGE(bufoff, gbase, voff) do { _Pragma("unroll") for (int _i = 0; _i < 2; ++_i) \
        __builtin_amdgcn_global_load_lds((const unsigned*)((const char*)(gbase) + (voff)[_i]), (PG8_LAS unsigned*)(lds + (bufoff) + ldsw + _i * 8192), 16, 0, 0); } while (0)
#define PG8_LDA(dst, b, h) do { _Pragma("unroll") for (int m = 0; m < 4; ++m) _Pragma("unroll") for (int k = 0; k < 2; ++k) dst[m][k] = *(const PG8_LAS bf16x8*)(lds + PG8_SA(b, h) + aoff + m * 2048 + k * 1024); } while (0)
#define PG8_LDB(dst, b, h) do { _Pragma("unroll") for (int n = 0; n < 2; ++n) _Pragma("unroll") for (int k = 0; k < 2; ++k) dst[n][k] = *(const PG8_LAS bf16x8*)(lds + PG8_SB(b, h) + boff + n * 2048 + k * 1024); } while (0)
#define PG8_MMA(ai, bj, At, Bt) do { __builtin_amdgcn_s_setprio(1); _Pragma("unroll") for (int m = 0; m < 4; ++m) _Pragma("unroll") for (int n = 0; n < 2; ++n) _Pragma("unroll") for (int k = 0; k < 2; ++k) \
        acc[ai][bj][m][n] = __builtin_amdgcn_mfma_f32_16x16x32_bf16(Bt[n][k], At[m][k], acc[ai][bj][m][n], 0, 0, 0); __builtin_amdgcn_s_setprio(0); } while (0)
#define PG8_WAIT_V(n) asm volatile("s_waitcnt vmcnt(" #n ")" ::: "memory")
#define PG8_WAIT_L(n) asm volatile("s_waitcnt lgkmcnt(" #n ")" ::: "memory")
#define PG8_BAR __builtin_amdgcn_s_barrier()
#define PG8_SCHED __builtin_amdgcn_sched_barrier(0)
    Unit cur, nxt; int ui = 0;
    if (!S.next(0, cur)) return;
    f32x4 acc[2][2][4][2];
#pragma unroll
    for (int a = 0; a < 2; ++a)
#pragma unroll
        for (int b = 0; b < 2; ++b)
#pragma unroll
            for (int m = 0; m < 4; ++m)
#pragma unroll
                for (int n = 0; n < 2; ++n) acc[a][b][m][n] = (f32x4){0.f, 0.f, 0.f, 0.f};
    bf16x8 At[4][2], B0[2][2], B1[2][2];
    const char* cA = (const char*)g.A + (size_t)cur.pm * tstep; const char* cB = (const char*)g.Bt + (size_t)cur.pn * tstep;
    S.a_ready(cur);
    PG8_STAGE(PG8_SB(0, 0), cB, voffB); PG8_STAGE(PG8_SA(0, 0), cA, voffA); PG8_STAGE(PG8_SB(0, 1), cB + hstep, voffB); PG8_STAGE(PG8_SA(0, 1), cA + hstep, voffA);
    if (wr == 1) PG8_BAR;
    PG8_WAIT_V(4); PG8_BAR;
    PG8_STAGE(PG8_SB(1, 0), cB + kstep, voffB); PG8_STAGE(PG8_SA(1, 0), cA + kstep, voffA); PG8_STAGE(PG8_SB(1, 1), cB + hstep + kstep, voffB);
    PG8_WAIT_V(6); PG8_BAR;
    for (;;) {
        const bool has_next = S.next(ui + 1, nxt);
        const char* nA = has_next ? (const char*)g.A + (size_t)nxt.pm * tstep : cA; const char* nB = has_next ? (const char*)g.Bt + (size_t)nxt.pn * tstep : cB;
        for (int t = 0; t < nt; t += 2) {
            const bool last = (t == nt - 2);
            const char* a1 = cA + (size_t)(t + 1) * kstep;
            const char* a2 = last ? nA : cA + (size_t)(t + 2) * kstep; const char* b2 = last ? nB : cB + (size_t)(t + 2) * kstep;
            const char* a3 = a2 + kstep; const char* b3 = b2 + kstep;
            if (last && has_next) S.a_ready(nxt);
            PG8_LDB(B0, 0, 0); PG8_SCHED; PG8_LDA(At, 0, 0); PG8_STAGE(PG8_SA(1, 1), a1 + hstep, voffA);
            PG8_WAIT_L(8); PG8_BAR; PG8_WAIT_L(0); PG8_MMA(0, 0, At, B0); PG8_BAR; PG8_SCHED;
            PG8_LDB(B1, 0, 1); PG8_STAGE(PG8_SB(0, 0), b2, voffB);
            PG8_BAR; PG8_WAIT_L(0); PG8_MMA(0, 1, At, B1); PG8_BAR;
            PG8_LDA(At, 0, 1); PG8_STAGE(PG8_SA(0, 0), a2, voffA);
            PG8_BAR; PG8_WAIT_L(0); PG8_MMA(1, 0, At, B0); PG8_BAR; PG8_SCHED;
            PG8_STAGE(PG8_SB(0, 1), b2 + hstep, voffB);
            PG8_WAIT_V(6); PG8_BAR; PG8_MMA(1, 1, At, B1); PG8_BAR;
            PG8_LDB(B0, 1, 0); PG8_SCHED; PG8_LDA(At, 1, 0); PG8_STAGE(PG8_SA(0, 1), a2 + hstep, voffA);
            PG8_WAIT_L(8); PG8_BAR; PG8_WAIT_L(0); PG8_MMA(0, 0, At, B0); PG8_BAR; PG8_SCHED;
            PG8_LDB(B1, 1, 1); PG8_STAGE(PG8_SB(1, 0), b3, voffB);
            PG8_BAR; PG8_WAIT_L(0); PG8_MMA(0, 1, At, B1); PG8_BAR;
            PG8_LDA(At, 1, 1); PG8_STAGE(PG8_SA(1, 0), a3, voffA);
            PG8_BAR; PG8_WAIT_L(0); PG8_MMA(1, 0, At, B0); PG8_BAR; PG8_SCHED;
            PG8_STAGE(PG8_SB(1, 1), b3 + hstep, voffB);
            PG8_WAIT_V(6); PG8_BAR; PG8_MMA(1, 1, At, B1); PG8_BAR;
        }
        if constexpr (!Epi::AFTER_DRAIN) { E(acc, cur, wr, wc, fr, fq); S.done(cur); }
        if (!has_next) break;
#pragma unroll
        for (int a = 0; a < 2; ++a)
#pragma unroll
            for (int b = 0; b < 2; ++b)
#pragma unroll
                for (int m = 0; m < 4; ++m)
#pragma unroll
                    for (int n = 0; n < 2; ++n) acc[a][b][m][n] = (f32x4){0.f, 0.f, 0.f, 0.f};
        cur = nxt; cA = nA; cB = nB; ++ui;
    }
    PG8_WAIT_V(0);
    if (wr == 0) PG8_BAR;
    PG8_BAR;
    if constexpr (Epi::AFTER_DRAIN) { E.fused(acc, cur, wr, wc, fr, fq, lds, wid, lane); S.done(cur); }
#undef PG8_SA
#undef PG8_SB
#undef PG8_STAGE
#undef PG8_LDA
#undef PG8_LDB
#undef PG8_MMA
#undef PG8_WAIT_V
#undef PG8_WAIT_L
#undef PG8_BAR
#undef PG8_SCHED
}
}
#define LAS __attribute__((address_space(3)))
#define XB_TMO      128
#define XB_XCNT(j)  (256  + 64 * (j))
#define XB_XSUB(j)  (1280 + 64 * (j))
#define XB_XGEN(j)  (2304 + 64 * (j))
#define XB_TOP      3328
#define XB_TOPGEN   3392
#define XCD_BAR_WORDS 3456
#define XB_SPIN_CAP (1u << 18)

__device__ __forceinline__ unsigned xb_ld(unsigned* p)              { return __hip_atomic_load(p, __ATOMIC_RELAXED, __HIP_MEMORY_SCOPE_AGENT); }
__device__ __forceinline__ unsigned xb_add(unsigned* p, unsigned v) { return __hip_atomic_fetch_add(p, v, __ATOMIC_RELAXED, __HIP_MEMORY_SCOPE_AGENT); }
__device__ __forceinline__ unsigned xb_xcc_id() { return (unsigned)__builtin_amdgcn_s_getreg((3 << 11) | 20) & 0xFu; }
#define XB_SPIN(cond, bar) do { unsigned _sp = 0; while (cond) { __builtin_amdgcn_s_sleep(1); \
    if ((++_sp & 255u) == 0u) { if (xb_ld(&(bar)[XB_TMO])) break; if (_sp > XB_SPIN_CAP) { atomicAdd(&(bar)[XB_TMO], 1u); break; } } } } while (0)

struct XcdBarrier {
    unsigned* bar; unsigned x;
    volatile LAS unsigned* st;
};

__device__ __forceinline__ XcdBarrier xcd_barrier_post(unsigned* bar, volatile LAS unsigned* st) {
    XcdBarrier b; b.bar = bar; b.x = xb_xcc_id(); b.st = st;
    if (threadIdx.x == 0) (void)xb_add(&bar[XB_XCNT(b.x)], 1u);
    return b;
}
__device__ __forceinline__ void xcd_barrier_complete(unsigned* bar, unsigned x, unsigned& nloc, unsigned& nx) {
    const unsigned G = gridDim.x * gridDim.y * gridDim.z;
    unsigned sum, cnt, mine, sp = 0u;
    for (;;) {
        sum = 0u; cnt = 0u; mine = 0u;
#pragma unroll
        for (unsigned j = 0; j < 16; ++j) { const unsigned c = xb_ld(&bar[XB_XCNT(j)]); sum += c; cnt += (c > 0u) ? 1u : 0u; mine = (j == x) ? c : mine; }
        if (sum == G) break;
        __builtin_amdgcn_s_sleep(1);
        if ((++sp & 255u) == 0u) { if (xb_ld(&bar[XB_TMO])) break; if (sp > XB_SPIN_CAP) { atomicAdd(&bar[XB_TMO], 1u); break; } }
    }
    nloc = mine > 0u ? mine : 1u; nx = cnt > 0u ? cnt : 1u;
}

__device__ __forceinline__ void xcd_barrier(const XcdBarrier& b) {
    asm volatile("s_waitcnt vmcnt(0)" ::: "memory");
    __syncthreads();
    if (threadIdx.x == 0) {
        unsigned* bar = b.bar;
        __builtin_amdgcn_s_waitcnt(0);
        unsigned nloc = b.st[0], nx = b.st[1];
        if (nloc == 0u) { xcd_barrier_complete(bar, b.x, nloc, nx); b.st[0] = nloc; b.st[1] = nx; }
        const unsigned old = xb_add(&bar[XB_XSUB(b.x)], 1u);
        const unsigned gen = old / nloc;
        if (old + 1u == (gen + 1u) * nloc) {
            __builtin_amdgcn_fence(__ATOMIC_RELEASE, "agent");
            asm volatile("s_waitcnt vmcnt(0)" ::: "memory");
            const unsigned og = xb_add(&bar[XB_TOP], 1u);
            const unsigned tg = og / nx;
            if (og + 1u == (tg + 1u) * nx) xb_add(&bar[XB_TOPGEN], 1u);
            else XB_SPIN(xb_ld(&bar[XB_TOPGEN]) == tg, bar);
            __builtin_amdgcn_fence(__ATOMIC_ACQUIRE, "agent");
            xb_add(&bar[XB_XGEN(b.x)], 1u);
            asm volatile("s_waitcnt vmcnt(0)" ::: "memory");
        } else {
            XB_SPIN(xb_ld(&bar[XB_XGEN(b.x)]) == gen, bar);
            __builtin_amdgcn_fence(__ATOMIC_ACQUIRE, "agent");
            asm volatile("s_waitcnt vmcnt(0)" ::: "memory");
        }
    }
    __syncthreads();
}

using pg8::bf16_t; using pg8::bf16x8; using pg8::f32x4; using pg8::u32x4; using pg8::Unit;
typedef unsigned u32x2 __attribute__((ext_vector_type(2)));
typedef short s16x4 __attribute__((ext_vector_type(4)));
typedef float f32x2v __attribute__((ext_vector_type(2)));
typedef __bf16 bf16v2 __attribute__((ext_vector_type(2)));
#define DI __device__ __forceinline__

constexpr int T = 32768, SEQ = 8192, D = 1024, FF = 2816;
constexpr int NTHREADS = 512;
constexpr int LDS_MAIN = 147456, LDS_BYTES = LDS_MAIN + 16;
constexpr size_t MiB = (size_t)1 << 20;
constexpr size_t W_IN0 = 0, W_OUT0 = 7 * MiB, W_IN1 = 9 * MiB, W_OUT1 = 27 * MiB, W_GU0 = 29 * MiB, W_GU1 = 40 * MiB, W_DN0 = 51 * MiB, W_DN1 = 57 * MiB,
                 W_PG0 = 63 * MiB, W_PG1 = 65 * MiB, W_PP0 = 67 * MiB, W_PP1 = 67 * MiB + MiB / 2;
constexpr size_t OFF_XB = 68 * MiB, OFF_PB = 132 * MiB, OFF_SS0 = 164 * MiB, OFF_SS1 = 166 * MiB, OFF_COS = 168 * MiB, OFF_SIN = 170 * MiB, OFF_GATES = 172 * MiB, OFF_LSE = 176 * MiB, OFF_BAR = 178 * MiB;
constexpr size_t OFF_R = 180 * MiB, OFF_PROJ0 = OFF_R, OFF_HG = OFF_R + 192 * MiB, OFF_HID = OFF_R, OFF_PPB = OFF_R + 192 * MiB, OFF_PROJ1 = OFF_R, OFF_OG = OFF_XB;
constexpr size_t OFF_GP = 436 * MiB;
constexpr size_t WS_END = 500 * MiB;
constexpr int NPH = 20;

struct Params { const float* in[18]; float* out; unsigned char* ws; float inv_freq[16]; int ph_lo, ph_hi; unsigned repmask, pad; };

DI unsigned pk2(float lo, float hi) { f32x2v v = {lo, hi}; bf16v2 b = __builtin_convertvector(v, bf16v2); return __builtin_bit_cast(unsigned, b); }
DI float bflo(unsigned w) { return __uint_as_float(w << 16); }
DI float bfhi(unsigned w) { return __uint_as_float(w & 0xffff0000u); }
DI float sigmoidf_(float x) { return __builtin_amdgcn_rcpf(1.0f + __expf(-x)); }
DI float row_rs(const float* ss, int row) {
    const f32x4* p = (const f32x4*)(ss + (size_t)row * 16);
    const f32x4 a = p[0], b = p[1], c = p[2], d = p[3]; const f32x4 s = (a + b) + (c + d);
    return rsqrtf(((s[0] + s[1]) + (s[2] + s[3])) * (1.0f / 1024.0f) + 1e-6f);
}

DI f32x4 ss_ld(const float* ss, int row, int fq) { return *(const f32x4*)(ss + (size_t)row * 16 + 4 * fq); }
DI float ss_rs(const f32x4 v) { float s = (v[0] + v[1]) + (v[2] + v[3]); s += __shfl_xor(s, 16); s += __shfl_xor(s, 32); return rsqrtf(s * (1.0f / 1024.0f) + 1e-6f); }

struct EpiProj0 {
    static constexpr bool PERM = true, AFTER_DRAIN = false;
    bf16_t* O; float* gates; const float* gbias; const float* ss;
    DI void operator()(const f32x4 (&acc)[2][2][4][2], const Unit& u, int wr, int wc, int fr, int fq) const {
        const int row0 = u.pm * 256 + wr * 64 + fr;
        f32x4 sva[2][4]; float rsa[2][4];
#pragma unroll
        for (int ai = 0; ai < 2; ++ai)
#pragma unroll
            for (int m = 0; m < 4; ++m) sva[ai][m] = ss_ld(ss, row0 + ai * 128 + m * 16, fq);
#pragma unroll
        for (int ai = 0; ai < 2; ++ai)
#pragma unroll
            for (int m = 0; m < 4; ++m) rsa[ai][m] = ss_rs(sva[ai][m]);
#pragma unroll
        for (int ai = 0; ai < 2; ++ai) { const float (&rs)[4] = rsa[ai];
            if (u.pn < 12) { const int col0 = u.pn * 256 + wc * 32 + 8 * fq;
#pragma unroll
                for (int m = 0; m < 4; ++m) { bf16_t* rowp = O + (size_t)(row0 + ai * 128 + m * 16) * 3072 + col0;
#pragma unroll
                    for (int bj = 0; bj < 2; ++bj) { const f32x4 v0 = acc[ai][bj][m][0] * rs[m], v1 = acc[ai][bj][m][1] * rs[m];
                        u32x4 w; w.x = pk2(v0[0], v0[1]); w.y = pk2(v0[2], v0[3]); w.z = pk2(v1[0], v1[1]); w.w = pk2(v1[2], v1[3]);
                        *(u32x4*)(rowp + bj * 128) = w; } }
            } else if (wc == 0) {
#pragma unroll
                for (int m = 0; m < 4; ++m)
#pragma unroll
                    for (int n = 0; n < 2; ++n) { const f32x4 bv = *(const f32x4*)(gbias + 8 * fq + 4 * n);
                        *(f32x4*)(gates + (size_t)(row0 + ai * 128 + m * 16) * 32 + 8 * fq + 4 * n) = acc[ai][0][m][n] * rs[m] + bv; }
            }
        }
    }
};
template <bool HF32> struct EpiRes {
    static constexpr bool PERM = true, AFTER_DRAIN = false;
    const void* hin; bf16_t* xout; float* ssw;
    DI void operator()(const f32x4 (&acc)[2][2][4][2], const Unit& u, int wr, int wc, int fr, int fq) const {
        const int row0 = u.pm * 256 + wr * 64 + fr, col0 = u.pn * 256 + wc * 32 + 8 * fq;
#pragma unroll
        for (int ai = 0; ai < 2; ++ai) {
            if (HF32) {
#pragma unroll
                for (int mh = 0; mh < 4; mh += 2) { f32x4 hv[2][2][2];
#pragma unroll
                    for (int m = 0; m < 2; ++m)
#pragma unroll
                        for (int bj = 0; bj < 2; ++bj)
#pragma unroll
                            for (int n = 0; n < 2; ++n) hv[m][bj][n] = *(const f32x4*)((const float*)hin + (size_t)(row0 + ai * 128 + (mh + m) * 16) * D + col0 + bj * 128 + n * 4);
#pragma unroll
                    for (int m = 0; m < 2; ++m) { const int row = row0 + ai * 128 + (mh + m) * 16; float sq = 0.f;
#pragma unroll
                        for (int bj = 0; bj < 2; ++bj) { const f32x4 o0 = hv[m][bj][0] + acc[ai][bj][mh + m][0], o1 = hv[m][bj][1] + acc[ai][bj][mh + m][1];
                            u32x4 w; w.x = pk2(o0[0], o0[1]); w.y = pk2(o0[2], o0[3]); w.z = pk2(o1[0], o1[1]); w.w = pk2(o1[2], o1[3]); *(u32x4*)(xout + (size_t)row * D + col0 + bj * 128) = w;
#pragma unroll
                            for (int j = 0; j < 4; ++j) { const float r0 = bflo(w[j]), r1 = bfhi(w[j]); sq += r0 * r0 + r1 * r1; } }
                        sq += __shfl_xor(sq, 16); sq += __shfl_xor(sq, 32);
                        if (fq == 0) ssw[(size_t)row * 16 + u.pn * 4 + wc] = sq; }
                    asm volatile("" ::: "memory"); }
            } else { u32x4 hv[4][2];
#pragma unroll
                for (int m = 0; m < 4; ++m)
#pragma unroll
                    for (int bj = 0; bj < 2; ++bj) hv[m][bj] = *(const u32x4*)((const bf16_t*)hin + (size_t)(row0 + ai * 128 + m * 16) * D + col0 + bj * 128);
#pragma unroll
                for (int m = 0; m < 4; ++m) { const int row = row0 + ai * 128 + m * 16; float sq = 0.f;
#pragma unroll
                    for (int bj = 0; bj < 2; ++bj) { const u32x4 hw = hv[m][bj];
                        const f32x4 o0 = f32x4{bflo(hw.x), bfhi(hw.x), bflo(hw.y), bfhi(hw.y)} + acc[ai][bj][m][0], o1 = f32x4{bflo(hw.z), bfhi(hw.z), bflo(hw.w), bfhi(hw.w)} + acc[ai][bj][m][1];
                        u32x4 w; w.x = pk2(o0[0], o0[1]); w.y = pk2(o0[2], o0[3]); w.z = pk2(o1[0], o1[1]); w.w = pk2(o1[2], o1[3]); *(u32x4*)(xout + (size_t)row * D + col0 + bj * 128) = w;
#pragma unroll
                        for (int j = 0; j < 4; ++j) { const float r0 = bflo(w[j]), r1 = bfhi(w[j]); sq += r0 * r0 + r1 * r1; } }
                    sq += __shfl_xor(sq, 16); sq += __shfl_xor(sq, 32);
                    if (fq == 0) ssw[(size_t)row * 16 + u.pn * 4 + wc] = sq; }
                asm volatile("" ::: "memory"); }
        }
    }
};
struct EpiFfnUp {
    static constexpr bool PERM = true, AFTER_DRAIN = false;
    bf16_t* hid; const float* ss;
    DI void operator()(const f32x4 (&acc)[2][2][4][2], const Unit& u, int wr, int wc, int fr, int fq) const {
        const int row0 = u.pm * 256 + wr * 64 + fr, col0 = u.pn * 128 + wc * 32 + 8 * fq;
        f32x4 sva[2][4]; float rsa[2][4];
#pragma unroll
        for (int ai = 0; ai < 2; ++ai)
#pragma unroll
            for (int m = 0; m < 4; ++m) sva[ai][m] = ss_ld(ss, row0 + ai * 128 + m * 16, fq);
#pragma unroll
        for (int ai = 0; ai < 2; ++ai)
#pragma unroll
            for (int m = 0; m < 4; ++m) rsa[ai][m] = ss_rs(sva[ai][m]);
#pragma unroll
        for (int ai = 0; ai < 2; ++ai) { const float (&rs)[4] = rsa[ai];
#pragma unroll
            for (int m = 0; m < 4; ++m) { unsigned wv[4];
#pragma unroll
                for (int n = 0; n < 2; ++n) { const f32x4 g = acc[ai][0][m][n] * rs[m], up = acc[ai][1][m][n] * rs[m]; f32x4 h;
#pragma unroll
                    for (int j = 0; j < 4; ++j) h[j] = g[j] * sigmoidf_(g[j]) * up[j];
                    wv[2 * n] = pk2(h[0], h[1]); wv[2 * n + 1] = pk2(h[2], h[3]); }
                u32x4 w; w.x = wv[0]; w.y = wv[1]; w.z = wv[2]; w.w = wv[3];
                *(u32x4*)(hid + (size_t)(row0 + ai * 128 + m * 16) * FF + col0) = w; } }
    }
};
struct EpiPlain {
    static constexpr bool PERM = true, AFTER_DRAIN = false;
    bf16_t* O; int ldc;
    DI void operator()(const f32x4 (&acc)[2][2][4][2], const Unit& u, int wr, int wc, int fr, int fq) const {
        const int row0 = u.pm * 256 + wr * 64 + fr, col0 = u.pn * 256 + wc * 32 + 8 * fq;
#pragma unroll
        for (int ai = 0; ai < 2; ++ai)
#pragma unroll
            for (int m = 0; m < 4; ++m) { bf16_t* rowp = O + (size_t)(row0 + ai * 128 + m * 16) * ldc + col0;
#pragma unroll
                for (int bj = 0; bj < 2; ++bj) { const f32x4 v0 = acc[ai][bj][m][0], v1 = acc[ai][bj][m][1];
                    u32x4 w; w.x = pk2(v0[0], v0[1]); w.y = pk2(v0[2], v0[3]); w.z = pk2(v1[0], v1[1]); w.w = pk2(v1[2], v1[3]);
                    *(u32x4*)(rowp + bj * 128) = w; } }
    }
};
struct EpiPle {
    static constexpr bool PERM = true, AFTER_DRAIN = false;
    const bf16_t* xin; bf16_t* xout; const bf16_t* pp; const float* ss; float* ssw;
    DI void operator()(const f32x4 (&acc)[2][2][4][2], const Unit& u, int wr, int wc, int fr, int fq) const {
        const int row0 = u.pm * 256 + wr * 64 + fr, col0 = u.pn * 256 + wc * 32 + 8 * fq;
#pragma unroll
        for (int ai = 0; ai < 2; ++ai)
#pragma unroll
            for (int mh = 0; mh < 4; mh += 2) { f32x4 sv[2]; u32x4 hv[2][2], pv[2][2]; float rs[2];
#pragma unroll
                for (int m = 0; m < 2; ++m) { sv[m] = ss_ld(ss, row0 + ai * 128 + (mh + m) * 16, fq);
#pragma unroll
                    for (int bj = 0; bj < 2; ++bj) { const size_t o2 = (size_t)(row0 + ai * 128 + (mh + m) * 16) * D + col0 + bj * 128; hv[m][bj] = *(const u32x4*)(xin + o2); pv[m][bj] = *(const u32x4*)(pp + o2); } }
#pragma unroll
                for (int m = 0; m < 2; ++m) rs[m] = ss_rs(sv[m]);
#pragma unroll
                for (int m = 0; m < 2; ++m) { const int row = row0 + ai * 128 + (mh + m) * 16; float sq = 0.f;
#pragma unroll
                    for (int bj = 0; bj < 2; ++bj) { const f32x4 a0 = acc[ai][bj][mh + m][0] * rs[m], a1 = acc[ai][bj][mh + m][1] * rs[m]; const u32x4 pw = pv[m][bj], hw = hv[m][bj]; f32x4 o0, o1;
                        o0[0] = bflo(hw.x) + sigmoidf_(a0[0]) * bflo(pw.x); o0[1] = bfhi(hw.x) + sigmoidf_(a0[1]) * bfhi(pw.x); o0[2] = bflo(hw.y) + sigmoidf_(a0[2]) * bflo(pw.y); o0[3] = bfhi(hw.y) + sigmoidf_(a0[3]) * bfhi(pw.y);
                        o1[0] = bflo(hw.z) + sigmoidf_(a1[0]) * bflo(pw.z); o1[1] = bfhi(hw.z) + sigmoidf_(a1[1]) * bfhi(pw.z); o1[2] = bflo(hw.w) + sigmoidf_(a1[2]) * bflo(pw.w); o1[3] = bfhi(hw.w) + sigmoidf_(a1[3]) * bfhi(pw.w);
                        u32x4 w; w.x = pk2(o0[0], o0[1]); w.y = pk2(o0[2], o0[3]); w.z = pk2(o1[0], o1[1]); w.w = pk2(o1[2], o1[3]); *(u32x4*)(xout + (size_t)row * D + col0 + bj * 128) = w;
#pragma unroll
                        for (int j = 0; j < 4; ++j) { const float r0 = bflo(w[j]), r1 = bfhi(w[j]); sq += r0 * r0 + r1 * r1; } }
                    sq += __shfl_xor(sq, 16); sq += __shfl_xor(sq, 32);
                    if (fq == 0) ssw[(size_t)row * 16 + u.pn * 4 + wc] = sq; }
                asm volatile("" ::: "memory"); }
    }
};
struct EpiProj1 {
    static constexpr bool PERM = true, AFTER_DRAIN = false;
    bf16_t* O; const float* ss; const float* cs; const float* sn; int rowbase;
    DI void operator()(const f32x4 (&acc)[2][2][4][2], const Unit& u, int wr, int wc, int fr, int fq) const {
        const int row0 = u.pm * 256 + wr * 64 + fr, col0 = u.pn * 256 + wc * 32 + 8 * fq;
        const bool rope = (((u.pn >> 2) % 3) < 2) && (wc == 0);
#pragma unroll
        for (int ai = 0; ai < 2; ++ai) { f32x4 sv[4]; float rs[4];
#pragma unroll
            for (int m = 0; m < 4; ++m) sv[m] = ss_ld(ss, rowbase + row0 + ai * 128 + m * 16, fq);
#pragma unroll
            for (int m = 0; m < 4; ++m) rs[m] = ss_rs(sv[m]);
            if (rope) {
#pragma unroll
                for (int mh = 0; mh < 4; mh += 2) { f32x4 c4[2], s4[2];
#pragma unroll
                    for (int m = 0; m < 2; ++m) { const int grow = rowbase + row0 + ai * 128 + (mh + m) * 16; c4[m] = *(const f32x4*)(cs + (size_t)grow * 16 + 4 * fq); s4[m] = *(const f32x4*)(sn + (size_t)grow * 16 + 4 * fq); }
#pragma unroll
                    for (int m = 0; m < 2; ++m) { bf16_t* rowp = O + (size_t)(row0 + ai * 128 + (mh + m) * 16) * 9216 + col0; const f32x4 c = c4[m], s = s4[m];
#pragma unroll
                        for (int bj = 0; bj < 2; ++bj) { const f32x4 v0 = acc[ai][bj][mh + m][0] * rs[mh + m], v1 = acc[ai][bj][mh + m][1] * rs[mh + m]; f32x4 r0, r1;
                            r0[0] = v0[0] * c[0] - v0[1] * s[0]; r0[1] = v0[1] * c[0] + v0[0] * s[0]; r0[2] = v0[2] * c[1] - v0[3] * s[1]; r0[3] = v0[3] * c[1] + v0[2] * s[1];
                            r1[0] = v1[0] * c[2] - v1[1] * s[2]; r1[1] = v1[1] * c[2] + v1[0] * s[2]; r1[2] = v1[2] * c[3] - v1[3] * s[3]; r1[3] = v1[3] * c[3] + v1[2] * s[3];
                            u32x4 w; w.x = pk2(r0[0], r0[1]); w.y = pk2(r0[2], r0[3]); w.z = pk2(r1[0], r1[1]); w.w = pk2(r1[2], r1[3]);
                            *(u32x4*)(rowp + bj * 128) = w; } } }
            } else {
#pragma unroll
                for (int m = 0; m < 4; ++m) { bf16_t* rowp = O + (size_t)(row0 + ai * 128 + m * 16) * 9216 + col0;
#pragma unroll
                    for (int bj = 0; bj < 2; ++bj) { const f32x4 v0 = acc[ai][bj][m][0] * rs[m], v1 = acc[ai][bj][m][1] * rs[m];
                        u32x4 w; w.x = pk2(v0[0], v0[1]); w.y = pk2(v0[2], v0[3]); w.z = pk2(v1[0], v1[1]); w.w = pk2(v1[2], v1[3]);
                        *(u32x4*)(rowp + bj * 128) = w; } }
            }
        }
    }
};

__device__ void prep_weight(LAS float* tile, const float* s0, const float* s1, const float* nrm, bf16_t* dst, int K, int Nsrc, int Ndst, int kind) {
    int tid_ = threadIdx.x; asm volatile("" : "+v"(tid_));
    const int tid = tid_; const int nkt = K / 64, ntiles = nkt * (Ndst / 64);
    LAS float* const tile_base = tile; int tb = 0;
    __syncthreads();
    for (int tl0 = blockIdx.x; tl0 < ntiles; tl0 += 4 * gridDim.x, tb ^= 1) {
#pragma unroll
        for (int u = 0; u < 4; ++u) { const int tl = tl0 + u * gridDim.x; if (tl >= ntiles) break;
            LAS float* tl_ = tile_base + (tb * 4 + u) * (64 * 65);
            const int n0 = (tl / nkt) * 64, k0 = (tl % nkt) * 64;
            const bool scalar_path = (kind == 2) && (((n0 >> 10) % 3) < 2) && ((n0 & 127) == 0);
            if (!scalar_path) { const int g4 = (tid & 15) * 4, n = n0 + g4; const float* src = s0; int col = n; float sc = 1.f; bool valid = true;
                if (kind == 1) { valid = n < 3104; if (n < 512) sc = 0.125f; }
                else if (kind == 3) { const int t = n >> 8, half = (n >> 7) & 1, j = n & 127; col = t * 128 + j; if (half) src = s1; }
#pragma unroll
                for (int i = 0; i < 2; ++i) { const int kl = (tid >> 4) + 32 * i; f32x4 v = {0.f, 0.f, 0.f, 0.f};
                    if (valid) { v = *(const f32x4*)(src + (size_t)(k0 + kl) * Nsrc + col) * sc; if (nrm) v *= nrm[k0 + kl]; }
                    tl_[kl * 65 + g4] = v[0]; tl_[kl * 65 + g4 + 1] = v[1]; tl_[kl * 65 + g4 + 2] = v[2]; tl_[kl * 65 + g4 + 3] = v[3]; }
            } else { const int nl = tid & 63, n = n0 + nl, d = n & 127; const int col = (d < 32) ? n - d + ((d & 1) ? 16 + (d >> 1) : (d >> 1)) : n;
#pragma unroll
                for (int i = 0; i < 8; ++i) { const int kl = (tid >> 6) + 8 * i; float v = s0[(size_t)(k0 + kl) * Nsrc + col]; if (nrm) v *= nrm[k0 + kl];
                    tl_[kl * 65 + nl] = v; } } }
        __syncthreads();
#pragma unroll
        for (int u = 0; u < 4; ++u) { const int tl = tl0 + u * gridDim.x; if (tl >= ntiles) break;
            const LAS float* tl_ = tile_base + (tb * 4 + u) * (64 * 65);
            const int n0 = (tl / nkt) * 64, k0 = (tl % nkt) * 64;
            const int nl = tid >> 3, ks = (tid & 7) * 8; float v[8];
#pragma unroll
            for (int j = 0; j < 8; ++j) v[j] = tl_[(ks + j) * 65 + nl];
            u32x4 w; w.x = pk2(v[0], v[1]); w.y = pk2(v[2], v[3]); w.z = pk2(v[4], v[5]); w.w = pk2(v[6], v[7]);
            *(u32x4*)(dst + (size_t)(n0 + nl) * K + k0 + ks) = w; }
    }
}
__device__ void prep_misc(const float* in_x, const float* in_p, const int* in_pos, unsigned char* ws, const __attribute__((address_space(4))) float* inv_freq_tab) {
    int tid_ = threadIdx.x; asm volatile("" : "+v"(tid_));
    const int tid = tid_, lane = tid & 63, wv = tid >> 6;
    { const float* x = in_x; bf16_t* xb = (bf16_t*)(ws + OFF_XB); float* ss = (float*)(ws + OFF_SS0);
      for (int row0 = (blockIdx.x * 8 + wv) * 4; row0 < T; row0 += gridDim.x * 32) { f32x4 v[4][2][2];
#pragma unroll
          for (int r = 0; r < 4; ++r)
#pragma unroll
              for (int i = 0; i < 2; ++i) { const float* q = x + (size_t)(row0 + r) * D + (i * 64 + lane) * 8; v[r][i][0] = *(const f32x4*)q; v[r][i][1] = *(const f32x4*)(q + 4); }
#pragma unroll
          for (int r = 0; r < 4; ++r) { float sq = 0.f;
#pragma unroll
              for (int i = 0; i < 2; ++i) { const f32x4 t0 = v[r][i][0], t1 = v[r][i][1];
                  sq += ((t0[0] * t0[0] + t0[1] * t0[1]) + (t0[2] * t0[2] + t0[3] * t0[3])) + ((t1[0] * t1[0] + t1[1] * t1[1]) + (t1[2] * t1[2] + t1[3] * t1[3]));
                  u32x4 w; w.x = pk2(t0[0], t0[1]); w.y = pk2(t0[2], t0[3]); w.z = pk2(t1[0], t1[1]); w.w = pk2(t1[2], t1[3]); *(u32x4*)(xb + (size_t)(row0 + r) * D + (i * 64 + lane) * 8) = w; }
#pragma unroll
              for (int o = 32; o >= 1; o >>= 1) sq += __shfl_xor(sq, o);
              if (lane < 16) ss[(size_t)(row0 + r) * 16 + lane] = (lane == 0) ? sq : 0.f; } } }
    { const float* p = in_p; bf16_t* pb = (bf16_t*)(ws + OFF_PB); const size_t n8 = (size_t)2 * T * 256 / 8, stride = (size_t)gridDim.x * NTHREADS;
      for (size_t i = (size_t)blockIdx.x * NTHREADS + tid; i < n8; i += 4 * stride) { f32x4 v[4][2];
#pragma unroll
          for (int r = 0; r < 4; ++r) if (i + r * stride < n8) { v[r][0] = *(const f32x4*)(p + (i + r * stride) * 8); v[r][1] = *(const f32x4*)(p + (i + r * stride) * 8 + 4); }
#pragma unroll
          for (int r = 0; r < 4; ++r) if (i + r * stride < n8) { u32x4 w; w.x = pk2(v[r][0][0], v[r][0][1]); w.y = pk2(v[r][0][2], v[r][0][3]); w.z = pk2(v[r][1][0], v[r][1][1]); w.w = pk2(v[r][1][2], v[r][1][3]); *(u32x4*)(pb + (i + r * stride) * 8) = w; } } }
    { const int* pos = in_pos; float* cs = (float*)(ws + OFF_COS); float* sn = (float*)(ws + OFF_SIN);
      for (int i = blockIdx.x * NTHREADS + tid; i < T * 16; i += gridDim.x * NTHREADS) { const float ang = (float)pos[i >> 4] * inv_freq_tab[i & 15];
          const double rev = (double)ang * 0.15915494309189535; const float fr = (float)(rev - rint(rev));
          cs[i] = __builtin_amdgcn_cosf(fr); sn[i] = __builtin_amdgcn_sinf(fr); } }
}

DI bf16x8 tr_read2(unsigned a_lo, unsigned a_hi) {
    s16x4 lo, hi;
    asm volatile("ds_read_b64_tr_b16 %0, %2\n\tds_read_b64_tr_b16 %1, %3\n\ts_waitcnt lgkmcnt(0)" : "=&v"(lo), "=&v"(hi) : "v"(a_lo), "v"(a_hi) : "memory");
    return __builtin_shufflevector(lo, hi, 0, 1, 2, 3, 4, 5, 6, 7);
}
DI void tr_read8(unsigned a0, unsigned a1, unsigned a2, unsigned a3, unsigned a4, unsigned a5, unsigned a6, unsigned a7, bf16x8& r0, bf16x8& r1, bf16x8& r2, bf16x8& r3) {
    s16x4 t0, t1, t2, t3, t4, t5, t6, t7;
    asm volatile("ds_read_b64_tr_b16 %0, %8\n\tds_read_b64_tr_b16 %1, %9\n\tds_read_b64_tr_b16 %2, %10\n\tds_read_b64_tr_b16 %3, %11\n\t"
                 "ds_read_b64_tr_b16 %4, %12\n\tds_read_b64_tr_b16 %5, %13\n\tds_read_b64_tr_b16 %6, %14\n\tds_read_b64_tr_b16 %7, %15\n\ts_waitcnt lgkmcnt(0)"
                 : "=&v"(t0), "=&v"(t1), "=&v"(t2), "=&v"(t3), "=&v"(t4), "=&v"(t5), "=&v"(t6), "=&v"(t7)
                 : "v"(a0), "v"(a1), "v"(a2), "v"(a3), "v"(a4), "v"(a5), "v"(a6), "v"(a7) : "memory");
    r0 = __builtin_shufflevector(t0, t1, 0, 1, 2, 3, 4, 5, 6, 7); r1 = __builtin_shufflevector(t2, t3, 0, 1, 2, 3, 4, 5, 6, 7);
    r2 = __builtin_shufflevector(t4, t5, 0, 1, 2, 3, 4, 5, 6, 7); r3 = __builtin_shufflevector(t6, t7, 0, 1, 2, 3, 4, 5, 6, 7);
}
DI s16x4 tr_read1(unsigned a) { s16x4 r; asm volatile("ds_read_b64_tr_b16 %0, %1\n\ts_waitcnt lgkmcnt(0)" : "=&v"(r) : "v"(a) : "memory"); return r; }
DI bf16x8 pack8(const f32x4& a, const f32x4& b) { u32x4 w; w.x = pk2(a[0], a[1]); w.y = pk2(a[2], a[3]); w.z = pk2(b[0], b[1]); w.w = pk2(b[2], b[3]); return __builtin_bit_cast(bf16x8, w); }

__device__ void mlstm_chunk(unsigned char* ldsg, const bf16_t* proj0, const float* gates, float* gpre, bf16_t* hf, bf16_t* hb) {
    LAS unsigned char* L = (LAS unsigned char*)ldsg; const unsigned lbase = (unsigned)(size_t)ldsg;
    constexpr int QP = 144, VP = 112;
    constexpr int OQ = 0, OKK = OQ + 2 * 64 * QP, OV = OKK + 2 * 64 * QP, OG = OV + 2 * 64 * VP, OVW = OG + 2 * 320 * 4, OC = OVW + 2 * 64 * VP, OCH = OC + 2 * 48 * QP;
    int tid_ = threadIdx.x; asm volatile("" : "+v"(tid_));
    const int tid = tid_, lane = tid & 63, w = __builtin_amdgcn_readfirstlane(tid >> 6), i16 = lane & 15, q4 = lane >> 4, lt = w & 3, half = w >> 2;
    const int ql_t = tid >> 3, ql_s = tid & 7, vl_t = (tid & 255) >> 2, vl_s = tid & 3;
    LAS float* chg = (LAS float*)(L + OCH); LAS float* cha = chg + 128; LAS float* chm = chg + 256; LAS float* chn = chg + 384; LAS float* chd = chg + 512;
    const int vb_ = ((gridDim.x & 7) == 0) ? (int)((blockIdx.x & 7) * (gridDim.x >> 3) + (blockIdx.x >> 3)) : (int)blockIdx.x;
    for (int unit = vb_; unit < 256; unit += gridDim.x) {
        const int dvq = unit & 3, dir = (unit >> 2) & 1, h = (unit >> 3) & 7, b = unit >> 6;
        bf16_t* hout = dir ? hb : hf;
        float* gp = gpre + (size_t)unit * 128 * 320;
        __syncthreads();
        {
#pragma unroll 1
            for (int i = 0; i < 16; ++i) { const int c = w + 8 * i; const int tb = b * SEQ + (dir ? SEQ - 64 * (c + 1) : 64 * c); const int tg = tb + (dir ? 63 - lane : lane);
                const float igv = gates[(size_t)tg * 32 + dir * 8 + h], fpv = gates[(size_t)tg * 32 + 16 + dir * 8 + h];
                float bc = -__logf(1.0f + __expf(-fpv));
#pragma unroll
                for (int o = 1; o < 64; o <<= 1) { const float t = __shfl_up(bc, o); if (lane >= o) bc += t; }
                const float gt = __shfl(bc, 63); float amax = gt - bc + igv;
#pragma unroll
                for (int o = 32; o >= 1; o >>= 1) amax = fmaxf(amax, __shfl_xor(amax, o));
                const float dd = igv - bc; float pm = dd;
#pragma unroll
                for (int o = 1; o < 64; o <<= 1) { const float t = __shfl_up(pm, o); if (lane >= o) pm = fmaxf(pm, t); }
                float* o_ = gp + (size_t)c * 320 + lane; o_[0] = bc; o_[64] = pm; o_[256] = dd;
                if (lane == 0) { chg[c] = gt; cha[c] = amax; } }
            __syncthreads();
            if (w == 0) {
                const float g0 = chg[lane], g1 = chg[64 + lane], a0 = cha[lane], a1 = cha[64 + lane];
                float m = 0.f, mp0 = 0.f, mp1 = 0.f, mn0 = 0.f, mn1 = 0.f, dc0 = 0.f, dc1 = 0.f;
                for (int c = 0; c < 64; ++c) { const float g = __shfl(g0, c), a = __shfl(a0, c); const float mn = fmaxf(g + m, a), dc = __expf(g + m - mn);
                    if (lane == c) { mp0 = m; mn0 = mn; dc0 = dc; } m = mn; }
                for (int c = 0; c < 64; ++c) { const float g = __shfl(g1, c), a = __shfl(a1, c); const float mn = fmaxf(g + m, a), dc = __expf(g + m - mn);
                    if (lane == c) { mp1 = m; mn1 = mn; dc1 = dc; } m = mn; }
                chm[lane] = mp0; chm[64 + lane] = mp1; chn[lane] = mn0; chn[64 + lane] = mn1; chd[lane] = dc0; chd[64 + lane] = dc1;
            }
            __syncthreads();
#pragma unroll 1
            for (int i = 0; i < 16; ++i) { const int c = w + 8 * i; const float mprev = chm[c], mnew = chn[c], gt = chg[c];
                float* o_ = gp + (size_t)c * 320 + lane; const float bc = o_[0], pm = o_[64], dd = o_[256];
                const float il = bc + mprev, mj = fmaxf(il, bc + pm);
                o_[0] = __expf(bc - mj); o_[64] = __expf(il - mj); o_[128] = __expf(-mj); o_[192] = __expf(gt + dd - mnew); o_[256] = __expf(dd); }
            asm volatile("s_waitcnt vmcnt(0)" ::: "memory");
            __syncthreads();
        }
        u32x4 rqA, rkA, rvA = {0u, 0u, 0u, 0u}, rqB, rkB, rvB = {0u, 0u, 0u, 0u}; float rgA = 0.f, raA = 0.f, rfA = 0.f, rgB = 0.f, raB = 0.f, rfB = 0.f;
        const long dstep = dir ? -(long)64 * 3072 : (long)64 * 3072;
        const bf16_t* qptr = proj0 + (size_t)(b * SEQ + (dir ? SEQ - 1 - ql_t : ql_t)) * 3072 + h * 64 + ql_s * 8;
        const bf16_t* vptr = proj0 + (size_t)(b * SEQ + (dir ? SEQ - 1 - vl_t : vl_t)) * 3072 + 1024 + h * 128 + dvq * 32 + vl_s * 8;
        const float* gptr = gp + tid; const float* aptr = gp + 192 + (tid < 256 ? vl_t : tid - 256);
#define CH_LOAD(ci, rq, rk, rv, rg, ra, rf) do { rq = *(const u32x4*)qptr; rk = *(const u32x4*)(qptr + 512); qptr += dstep; \
        if (tid < 256) { rv = *(const u32x4*)vptr; vptr += dstep; } \
        if (tid < 320) { ra = __builtin_nontemporal_load(aptr); rf = __builtin_nontemporal_load(aptr + 64); rg = __builtin_nontemporal_load(gptr); aptr += 320; gptr += 320; } } while (0)
#define CH_STORE(bb, rq, rk, rv, rg, ra, rf) do { *(LAS u32x4*)(L + OQ + (bb) * 64 * QP + ql_t * QP + ql_s * 16) = rq; *(LAS u32x4*)(L + OKK + (bb) * 64 * QP + ql_t * QP + ql_s * 16) = rk; \
        if (tid < 256) { u32x4 o_, f_; const float v0_ = bflo(rv.x), v1_ = bfhi(rv.x), v2_ = bflo(rv.y), v3_ = bfhi(rv.y), v4_ = bflo(rv.z), v5_ = bfhi(rv.z), v6_ = bflo(rv.w), v7_ = bfhi(rv.w); \
            o_.x = pk2(v0_ * ra, v1_ * ra); o_.y = pk2(v2_ * ra, v3_ * ra); o_.z = pk2(v4_ * ra, v5_ * ra); o_.w = pk2(v6_ * ra, v7_ * ra); \
            f_.x = pk2(v0_ * rf, v1_ * rf); f_.y = pk2(v2_ * rf, v3_ * rf); f_.z = pk2(v4_ * rf, v5_ * rf); f_.w = pk2(v6_ * rf, v7_ * rf); \
            *(LAS u32x4*)(L + OVW + (bb) * 64 * VP + vl_t * VP + vl_s * 16) = o_; *(LAS u32x4*)(L + OV + (bb) * 64 * VP + vl_t * VP + vl_s * 16) = f_; } \
        else if (tid < 320) { LAS unsigned char* r_ = L + OVW + (bb) * 64 * VP + (tid - 256) * VP + 64; *(LAS u32x4*)r_ = u32x4{pk2(ra, 0.f), 0u, 0u, 0u}; *(LAS u32x4*)(r_ + 16) = u32x4{0u, 0u, 0u, 0u}; \
            LAS unsigned char* q_ = L + OV + (bb) * 64 * VP + (tid - 256) * VP + 64; *(LAS u32x4*)q_ = u32x4{pk2(rf, 0.f), 0u, 0u, 0u}; *(LAS u32x4*)(q_ + 16) = u32x4{0u, 0u, 0u, 0u}; } \
        if (tid < 320) *(LAS float*)(L + OG + (bb) * 1280 + tid * 4) = rg; } while (0)
        CH_LOAD(0, rqA, rkA, rvA, rgA, raA, rfA); CH_STORE(0, rqA, rkA, rvA, rgA, raA, rfA);
        CH_LOAD(1, rqA, rkA, rvA, rgA, raA, rfA);
        for (int i = tid; i < 2 * 432; i += NTHREADS) *(LAS u32x4*)(L + OC + i * 16) = u32x4{0u, 0u, 0u, 0u};
        f32x4 Cacc[2]; Cacc[0] = f32x4{0.f, 0.f, 0.f, 0.f}; Cacc[1] = f32x4{0.f, 0.f, 0.f, 0.f};
        const long ostep = dir ? -(long)64 * D : (long)64 * D;
        bf16_t* optr = hout + (size_t)(b * SEQ + (dir ? SEQ - 1 - (16 * lt + i16) : 16 * lt + i16)) * D + h * 128 + dvq * 32 + 16 * half + 4 * q4;
        __syncthreads();
        for (int ci = 0; ci < 128; ++ci) {
            const int buf = ci & 1;
            if (ci + 2 < 128) CH_LOAD(ci + 2, rqB, rkB, rvB, rgB, raB, rfB);
            const LAS float* gq = (const LAS float*)(L + OG + buf * 1280);
            const int lq = 16 * lt + i16;
            const float e_l = gq[lq], iw_l = gq[64 + lq], emj_l = gq[128 + lq], decay = chd[ci];
            bf16x8 qf[2];
#pragma unroll
            for (int kk = 0; kk < 2; ++kk) qf[kk] = *(const LAS bf16x8*)(L + OQ + buf * 64 * QP + lq * QP + (32 * kk + 8 * q4) * 2);
            f32x4 ai0 = {0.f, 0.f, 0.f, 0.f}, ai1 = ai0, ax0 = ai0, ax1 = ai0;
            const LAS unsigned char* Cr = L + OC + buf * 48 * QP;
#pragma unroll
            for (int kk = 0; kk < 2; ++kk) { const bf16x8 c0 = *(const LAS bf16x8*)(Cr + (16 * half + i16) * QP + (32 * kk + 8 * q4) * 2), c1 = *(const LAS bf16x8*)(Cr + (32 + i16) * QP + (32 * kk + 8 * q4) * 2);
                ax0 = __builtin_amdgcn_mfma_f32_16x16x32_bf16(c0, qf[kk], ax0, 0, 0, 0); ax1 = __builtin_amdgcn_mfma_f32_16x16x32_bf16(c1, qf[kk], ax1, 0, 0, 0); }
            Cacc[0] *= decay; Cacc[1] *= decay;
            { const unsigned vwl = lbase + OVW + buf * 64 * VP + (i16 >> 2) * VP + (i16 & 3) * 8, kl = lbase + OKK + buf * 64 * QP + (i16 >> 2) * QP + (i16 & 3) * 8;
              const unsigned k0 = kl + (4 * q4) * QP + 32 * lt, k1 = k0 + 32 * QP, w0 = vwl + (4 * q4) * VP, w1 = w0 + 32 * VP; bf16x8 kb0, kb1, x00, x01, x10, x11, dmy0, dmy1;
              tr_read8(k0, k0 + 16 * QP, k1, k1 + 16 * QP, w0 + 32 * half, w0 + 16 * VP + 32 * half, w0 + 64, w0 + 16 * VP + 64, kb0, kb1, x00, x01);
              tr_read8(w1 + 32 * half, w1 + 16 * VP + 32 * half, w1 + 64, w1 + 16 * VP + 64, w1 + 32 * half, w1 + 16 * VP + 32 * half, w1 + 64, w1 + 16 * VP + 64, x10, x11, dmy0, dmy1);
              Cacc[0] = __builtin_amdgcn_mfma_f32_16x16x32_bf16(x00, kb0, Cacc[0], 0, 0, 0); Cacc[1] = __builtin_amdgcn_mfma_f32_16x16x32_bf16(x01, kb0, Cacc[1], 0, 0, 0);
              Cacc[0] = __builtin_amdgcn_mfma_f32_16x16x32_bf16(x10, kb1, Cacc[0], 0, 0, 0); Cacc[1] = __builtin_amdgcn_mfma_f32_16x16x32_bf16(x11, kb1, Cacc[1], 0, 0, 0); }
            { LAS unsigned char* Cw = L + OC + (buf ^ 1) * 48 * QP;
#pragma unroll
              for (int j = 0; j < 4; ++j) { *(LAS bf16_t*)(Cw + (16 * half + 4 * q4 + j) * QP + (16 * lt + i16) * 2) = (bf16_t)(pk2(Cacc[0][j], 0.f) & 0xffffu);
                  if (half == 0) *(LAS bf16_t*)(Cw + (32 + 4 * q4 + j) * QP + (16 * lt + i16) * 2) = (bf16_t)(pk2(Cacc[1][j], 0.f) & 0xffffu); } }
            f32x4 st[4];
#pragma unroll
            for (int t = 0; t < 4; ++t) { st[t] = f32x4{0.f, 0.f, 0.f, 0.f};
#pragma unroll
                for (int kk = 0; kk < 2; ++kk) { const bf16x8 kf = *(const LAS bf16x8*)(L + OKK + buf * 64 * QP + (16 * t + i16) * QP + (32 * kk + 8 * q4) * 2);
                    st[t] = __builtin_amdgcn_mfma_f32_16x16x32_bf16(kf, qf[kk], st[t], 0, 0, 0); } }
#pragma unroll
            for (int t = 0; t < 4; ++t)
#pragma unroll
                for (int j = 0; j < 4; ++j) { const int s = 16 * t + 4 * q4 + j; st[t][j] = (s <= lq) ? st[t][j] : 0.f; }
            const unsigned vl = lbase + OV + buf * 64 * VP + (i16 >> 2) * VP + (i16 & 3) * 8;
            { const bf16x8 pf0 = pack8(st[0], st[1]), pf1 = pack8(st[2], st[3]); const unsigned a0 = vl + (4 * q4) * VP, a1 = a0 + 32 * VP; bf16x8 v00, v01, v10, v11;
              tr_read8(a0 + 32 * half, a0 + 16 * VP + 32 * half, a0 + 64, a0 + 16 * VP + 64, a1 + 32 * half, a1 + 16 * VP + 32 * half, a1 + 64, a1 + 16 * VP + 64, v00, v01, v10, v11);
              ai0 = __builtin_amdgcn_mfma_f32_16x16x32_bf16(v00, pf0, ai0, 0, 0, 0); ai1 = __builtin_amdgcn_mfma_f32_16x16x32_bf16(v01, pf0, ai1, 0, 0, 0);
              ai0 = __builtin_amdgcn_mfma_f32_16x16x32_bf16(v10, pf1, ai0, 0, 0, 0); ai1 = __builtin_amdgcn_mfma_f32_16x16x32_bf16(v11, pf1, ai1, 0, 0, 0); }
            { const f32x4 num = ai0 * e_l + ax0 * iw_l; float den = ai1[0] * e_l + ax1[0] * iw_l; den = __shfl(den, i16);
              const float inv = 1.0f / fmaxf(fabsf(den), emj_l);
              u32x2 o; o.x = pk2(num[0] * inv, num[1] * inv); o.y = pk2(num[2] * inv, num[3] * inv);
              *(u32x2*)optr = o; optr += ostep; }
            if (ci + 1 < 128) CH_STORE(buf ^ 1, rqA, rkA, rvA, rgA, raA, rfA);
            rqA = rqB; rkA = rkB; rvA = rvB; rgA = rgB; raA = raB; rfA = rfB;
            __syncthreads();
        }
    }
#undef CH_LOAD
#undef CH_STORE
}
__device__ void mlstm_combine(bf16_t* hf, const bf16_t* hb, const bf16_t* proj0, const float* head_norm) {
    int tid_ = threadIdx.x; asm volatile("" : "+v"(tid_));
    const int lane = tid_ & 63, wv = tid_ >> 6, col = lane * 16;
    f32x4 hn[4];
#pragma unroll
    for (int j = 0; j < 4; ++j) hn[j] = *(const f32x4*)(head_norm + col + 4 * j);
    for (int tok0 = (blockIdx.x * 8 + wv) * 4; tok0 < T; tok0 += gridDim.x * 32) { u32x4 a[4][2], b[4][2], o[4][2];
#pragma unroll
        for (int t = 0; t < 4; ++t)
#pragma unroll
            for (int k = 0; k < 2; ++k) { const size_t off = (size_t)(tok0 + t) * D + col + 8 * k; a[t][k] = *(const u32x4*)(hf + off); b[t][k] = *(const u32x4*)(hb + off);
                o[t][k] = *(const u32x4*)(proj0 + (size_t)(tok0 + t) * 3072 + 2048 + col + 8 * k); }
#pragma unroll
        for (int t = 0; t < 4; ++t) { float h[16], og[16];
#pragma unroll
            for (int k = 0; k < 2; ++k)
#pragma unroll
                for (int j = 0; j < 4; ++j) { h[8 * k + 2 * j] = bflo(a[t][k][j]) + bflo(b[t][k][j]); h[8 * k + 2 * j + 1] = bfhi(a[t][k][j]) + bfhi(b[t][k][j]);
                    og[8 * k + 2 * j] = bflo(o[t][k][j]); og[8 * k + 2 * j + 1] = bfhi(o[t][k][j]); }
            float sq = 0.f;
#pragma unroll
            for (int j = 0; j < 16; ++j) sq += h[j] * h[j];
            sq += __shfl_xor(sq, 1); sq += __shfl_xor(sq, 2); sq += __shfl_xor(sq, 4);
            const float rs = rsqrtf(sq * (1.0f / 128.0f) + 1e-6f);
            float r[16];
#pragma unroll
            for (int j = 0; j < 16; ++j) r[j] = sigmoidf_(og[j]) * h[j] * rs * hn[j >> 2][j & 3];
            u32x4 w0, w1;
#pragma unroll
            for (int j = 0; j < 4; ++j) { w0[j] = pk2(r[2 * j], r[2 * j + 1]); w1[j] = pk2(r[8 + 2 * j], r[9 + 2 * j]); }
            *(u32x4*)(hf + (size_t)(tok0 + t) * D + col) = w0; *(u32x4*)(hf + (size_t)(tok0 + t) * D + col + 8) = w1; }
    }
}

__device__ void attn_phase(unsigned char* ldsg, const bf16_t* proj1, bf16_t* og0, bf16_t* og1, bf16_t* og2, float* lse) {
    LAS unsigned char* ldsl = (LAS unsigned char*)ldsg;
    const unsigned lds_base = (unsigned)(size_t)ldsg;
    int tid_ = threadIdx.x; asm volatile("" : "+v"(tid_));
    const int tid = tid_, lane = tid & 63, w = __builtin_amdgcn_readfirstlane(tid >> 6), i16 = lane & 15, q4 = lane >> 4;
    const float scale = 0.08838834764831845f;
    const int vb_ = ((gridDim.x & 7) == 0) ? (int)((blockIdx.x & 7) * (gridDim.x >> 3) + (blockIdx.x >> 3)) : (int)blockIdx.x;
    for (int uid = vb_; uid < 1536; uid += gridDim.x) {
        const int g = uid >> 9, rem = uid & 511, head = rem >> 6, jj = rem & 63;
        const int dsh = 2 * g, dil = 1 << dsh, U = SEQ >> dsh, nblk = U >> 7;
        const int r = jj / nblk, blk = jj % nblk, u0 = blk * 128;
        const bf16_t* qb = proj1 + g * 3072 + head * 128; const bf16_t* kb = qb + 1024; const bf16_t* vb = qb + 2048;
        {   u32x4 kr[8], vr[8];
#pragma unroll
            for (int i = 0; i < 8; ++i) { const int c = tid + 512 * i, kk = c >> 4, seg = c & 15, uk = u0 - 64 + kk; const bool ok = uk >= 0 && uk < U;
                const size_t off = (size_t)((ok ? uk : 0) * dil + r) * 9216 + seg * 8;
                kr[i] = *(const u32x4*)(kb + off); vr[i] = *(const u32x4*)(vb + off);
                if (!ok) { kr[i] = u32x4{0u, 0u, 0u, 0u}; vr[i] = u32x4{0u, 0u, 0u, 0u}; } }
#pragma unroll
            for (int i = 0; i < 8; ++i) { const int c = tid + 512 * i, kk = c >> 4, seg = c & 15;
                *(LAS u32x4*)(ldsl + kk * 288 + seg * 16) = kr[i]; *(LAS u32x4*)(ldsl + 73728 + kk * 288 + seg * 16) = vr[i]; } }
        __syncthreads();
        const int uq = u0 + 16 * w + i16; const size_t tokl = (size_t)uq * dil + r;
        bf16x8 qf[4];
#pragma unroll
        for (int kk = 0; kk < 4; ++kk) qf[kk] = *(const bf16x8*)(qb + tokl * 9216 + 32 * kk + 8 * q4);
        f32x4 s[9];
#pragma unroll
        for (int kt = 0; kt < 9; ++kt) { s[kt] = f32x4{0.f, 0.f, 0.f, 0.f};
#pragma unroll
            for (int kk = 0; kk < 4; ++kk) { const bf16x8 kf = *(const LAS bf16x8*)(ldsl + (16 * (w + kt) + i16) * 288 + (32 * kk + 8 * q4) * 2);
                s[kt] = __builtin_amdgcn_mfma_f32_16x16x32_bf16(kf, qf[kk], s[kt], 0, 0, 0); } }
        float mx = -1e30f;
#pragma unroll
        for (int kt = 0; kt < 9; ++kt)
#pragma unroll
            for (int j = 0; j < 4; ++j) { const int dl = 16 * kt - 64 + 4 * q4 + j - i16, uk = uq + dl; const bool ok = dl >= -64 && dl <= 64 && uk >= 0 && uk < U;
                const float v = ok ? s[kt][j] * scale : -1e30f; s[kt][j] = v; mx = fmaxf(mx, v); }
        mx = fmaxf(mx, __shfl_xor(mx, 16)); mx = fmaxf(mx, __shfl_xor(mx, 32));
        float l = 0.f;
#pragma unroll
        for (int kt = 0; kt < 9; ++kt)
#pragma unroll
            for (int j = 0; j < 4; ++j) { const float p = __expf(s[kt][j] - mx); s[kt][j] = p; l += p; }
        l += __shfl_xor(l, 16); l += __shfl_xor(l, 32);
        f32x4 o[8];
#pragma unroll
        for (int nt = 0; nt < 8; ++nt) o[nt] = f32x4{0.f, 0.f, 0.f, 0.f};
        const unsigned vlane = lds_base + 73728u + (unsigned)((i16 >> 2) * 288 + (i16 & 3) * 8);
#pragma unroll
        for (int s2 = 0; s2 < 4; ++s2) {
            u32x4 pw; pw.x = pk2(s[2 * s2][0], s[2 * s2][1]); pw.y = pk2(s[2 * s2][2], s[2 * s2][3]); pw.z = pk2(s[2 * s2 + 1][0], s[2 * s2 + 1][1]); pw.w = pk2(s[2 * s2 + 1][2], s[2 * s2 + 1][3]);
            const bf16x8 pf = __builtin_bit_cast(bf16x8, pw);
            const unsigned a0 = vlane + (unsigned)((16 * (w + 2 * s2) + 4 * q4) * 288);
#pragma unroll
            for (int n4 = 0; n4 < 8; n4 += 4) { bf16x8 v0, v1, v2, v3; const unsigned a1 = a0 + 32 * n4, a2 = a1 + 16 * 288;
                tr_read8(a1, a2, a1 + 32, a2 + 32, a1 + 64, a2 + 64, a1 + 96, a2 + 96, v0, v1, v2, v3);
                o[n4] = __builtin_amdgcn_mfma_f32_16x16x32_bf16(v0, pf, o[n4], 0, 0, 0); o[n4 + 1] = __builtin_amdgcn_mfma_f32_16x16x32_bf16(v1, pf, o[n4 + 1], 0, 0, 0);
                o[n4 + 2] = __builtin_amdgcn_mfma_f32_16x16x32_bf16(v2, pf, o[n4 + 2], 0, 0, 0); o[n4 + 3] = __builtin_amdgcn_mfma_f32_16x16x32_bf16(v3, pf, o[n4 + 3], 0, 0, 0); }
        }
        {   u32x2 pw; pw.x = pk2(s[8][0], s[8][1]); pw.y = pk2(s[8][2], s[8][3]); const s16x4 pf = __builtin_bit_cast(s16x4, pw);
            const unsigned a0 = vlane + (unsigned)((16 * (w + 8) + 4 * q4) * 288);
#pragma unroll
            for (int nt = 0; nt < 8; ++nt) { const s16x4 vf = tr_read1(a0 + 32 * nt); o[nt] = __builtin_amdgcn_mfma_f32_16x16x16bf16_1k(vf, pf, o[nt], 0, 0, 0); } }
        const float inv = 1.0f / l; const size_t orow = tokl * D + head * 128; bf16_t* og = g == 0 ? og0 : (g == 1 ? og1 : og2);
#pragma unroll
        for (int nt = 0; nt < 8; ++nt) { const f32x4 v = o[nt] * inv; u32x2 wv; wv.x = pk2(v[0], v[1]); wv.y = pk2(v[2], v[3]); *(u32x2*)(og + orow + 16 * nt + 4 * q4) = wv; }
        if (q4 == 0) lse[((size_t)g * SEQ + tokl) * 8 + head] = mx + __logf(l);
        __syncthreads();
    }
}
__device__ void attn_merge(const bf16_t* og0, const bf16_t* og1, const bf16_t* og2, const float* lse, bf16_t* obuf) {
    int tid_ = threadIdx.x; asm volatile("" : "+v"(tid_));
    const int lane = tid_ & 63, wv = tid_ >> 6, col = lane * 16, head = lane >> 3;
    for (int tok0 = (blockIdx.x * 8 + wv) * 2; tok0 < SEQ; tok0 += gridDim.x * 16) { u32x4 a[2][3][2]; float ls[2][3];
#pragma unroll
        for (int t = 0; t < 2; ++t)
#pragma unroll
            for (int g = 0; g < 3; ++g) { const bf16_t* og = g == 0 ? og0 : (g == 1 ? og1 : og2); const int tok = tok0 + t;
                ls[t][g] = lse[((size_t)g * SEQ + tok) * 8 + head]; a[t][g][0] = *(const u32x4*)(og + (size_t)tok * D + col); a[t][g][1] = *(const u32x4*)(og + (size_t)tok * D + col + 8); }
#pragma unroll
        for (int t = 0; t < 2; ++t) { const float M = fmaxf(ls[t][0], fmaxf(ls[t][1], ls[t][2]));
            float w0 = __expf(ls[t][0] - M), w1 = __expf(ls[t][1] - M), w2 = __expf(ls[t][2] - M); const float inv = 1.0f / (w0 + w1 + w2); w0 *= inv; w1 *= inv; w2 *= inv;
            float acc[16];
#pragma unroll
            for (int j = 0; j < 16; ++j) acc[j] = 0.f;
#pragma unroll
            for (int g = 0; g < 3; ++g) { const float wg = g == 0 ? w0 : (g == 1 ? w1 : w2);
#pragma unroll
                for (int j = 0; j < 4; ++j) { acc[2 * j] += wg * bflo(a[t][g][0][j]); acc[2 * j + 1] += wg * bfhi(a[t][g][0][j]); acc[8 + 2 * j] += wg * bflo(a[t][g][1][j]); acc[9 + 2 * j] += wg * bfhi(a[t][g][1][j]); } }
            u32x4 w0v, w1v;
#pragma unroll
            for (int j = 0; j < 4; ++j) { w0v[j] = pk2(acc[2 * j], acc[2 * j + 1]); w1v[j] = pk2(acc[8 + 2 * j], acc[9 + 2 * j]); }
            *(u32x4*)(obuf + (size_t)(tok0 + t) * D + col) = w0v; *(u32x4*)(obuf + (size_t)(tok0 + t) * D + col + 8) = w1v; }
    }
}
__device__ void final_norm(float* out, const bf16_t* xin, const float* ss, const float* fn) {
    int tid_ = threadIdx.x; asm volatile("" : "+v"(tid_));
    const int lane = tid_ & 63, wv = tid_ >> 6;
    f32x4 f[2][2];
#pragma unroll
    for (int i = 0; i < 2; ++i) { f[i][0] = *(const f32x4*)(fn + (i * 64 + lane) * 8); f[i][1] = *(const f32x4*)(fn + (i * 64 + lane) * 8 + 4); }
    for (int row0 = (blockIdx.x * 8 + wv) * 8; row0 < T; row0 += gridDim.x * 64) { u32x4 v[8][2]; float sp[8];
#pragma unroll
        for (int r = 0; r < 8; ++r) { sp[r] = ss[(size_t)(row0 + r) * 16 + (lane & 15)];
#pragma unroll
            for (int i = 0; i < 2; ++i) v[r][i] = *(const u32x4*)(xin + (size_t)(row0 + r) * D + (i * 64 + lane) * 8); }
#pragma unroll
        for (int r = 0; r < 8; ++r) { float s = sp[r]; s += __shfl_xor(s, 1); s += __shfl_xor(s, 2); s += __shfl_xor(s, 4); s += __shfl_xor(s, 8);
            const float rs = rsqrtf(s * (1.0f / 1024.0f) + 1e-6f);
#pragma unroll
            for (int i = 0; i < 2; ++i) { const u32x4 w = v[r][i]; float* o = out + (size_t)(row0 + r) * D + (i * 64 + lane) * 8;
                *(f32x4*)o = f32x4{bflo(w.x), bfhi(w.x), bflo(w.y), bfhi(w.y)} * rs * f[i][0];
                *(f32x4*)(o + 4) = f32x4{bflo(w.z), bfhi(w.z), bflo(w.w), bfhi(w.w)} * rs * f[i][1]; } } }
}

#ifndef PHMASK
#define PHMASK 0xFFFFFFFFu
#endif
#ifndef REPMASK
#define REPMASK 0u
#endif
#define EN(k) (((PHMASK) >> (k)) & 1u)
__global__ void __launch_bounds__(NTHREADS, 2) fwd_kernel(Params P) {
    extern __shared__ __attribute__((aligned(16))) unsigned char lds[];
    cg::grid_group grid = cg::this_grid();
    LAS unsigned char* ldsl = (LAS unsigned char*)lds;
    const int G = gridDim.x, bid = blockIdx.x;
    const int ph_lo = P.ph_lo, ph_hi = P.ph_hi;
    if (threadIdx.x < 4) ((LAS unsigned*)(ldsl + LDS_MAIN))[threadIdx.x] = 0u;
    __syncthreads();
    XcdBarrier xbar; xbar.bar = (unsigned*)(P.ws + OFF_BAR); xbar.x = 0; xbar.st = (volatile LAS unsigned*)(ldsl + LDS_MAIN);
    if (ph_hi - ph_lo > 1) xbar = xcd_barrier_post((unsigned*)(P.ws + OFF_BAR), (volatile LAS unsigned*)(ldsl + LDS_MAIN));
    if (ph_hi > 1000) grid.sync();
    for (int ph = ph_lo; ph < ph_hi; ++ph) {
        const __attribute__((address_space(4))) Params* PP = (const __attribute__((address_space(4))) Params*)__builtin_amdgcn_kernarg_segment_ptr();
        asm volatile("" : "+s"(PP));
        unsigned char* ws = PP->ws; float* const outp = PP->out;
        bf16_t* const xbA = (bf16_t*)(ws + OFF_XB); bf16_t* const xbB = (bf16_t*)outp; bf16_t* const obuf = (bf16_t*)outp + (size_t)T * D;
        int phx = ph; asm volatile("" : "+s"(phx));
        bf16_t* xb = (phx >= 8 && phx <= 18) ? xbB : xbA;
        float* ss0 = (float*)(ws + OFF_SS0); float* ss1 = (float*)(ws + OFF_SS1);
#define PIN(i) (PP->in[i])
        const int nrep = ((REPMASK >> ph) & 1u) ? 2 : 1;
        for (int rep = 0; rep < nrep; ++rep) {
        if (rep) __syncthreads();
        if (EN(0) && ph == 0) {
            LAS float* tile = (LAS float*)ldsl;
            prep_weight(tile, PIN(4), nullptr, PIN(3), (bf16_t*)(ws + W_IN0), 1024, 3104, 3328, 1);
            prep_weight(tile, PIN(7), nullptr, nullptr, (bf16_t*)(ws + W_OUT0), 1024, 1024, 1024, 0);
            prep_weight(tile, PIN(8), nullptr, PIN(3) + 1024, (bf16_t*)(ws + W_IN1), 1024, 9216, 9216, 2);
            prep_weight(tile, PIN(9), nullptr, nullptr, (bf16_t*)(ws + W_OUT1), 1024, 1024, 1024, 0);
            for (int l = 0; l < 2; ++l) {
                prep_weight(tile, PIN(11) + (size_t)l * 1024 * FF, PIN(12) + (size_t)l * 1024 * FF, PIN(10) + l * 1024, (bf16_t*)(ws + (l ? W_GU1 : W_GU0)), 1024, FF, 2 * FF, 3);
                prep_weight(tile, PIN(13) + (size_t)l * FF * 1024, nullptr, nullptr, (bf16_t*)(ws + (l ? W_DN1 : W_DN0)), FF, 1024, 1024, 0);
                prep_weight(tile, PIN(15) + (size_t)l * 1024 * 1024, nullptr, PIN(14) + l * 1024, (bf16_t*)(ws + (l ? W_PG1 : W_PG0)), 1024, 1024, 1024, 0);
                prep_weight(tile, PIN(16) + (size_t)l * 256 * 1024, nullptr, nullptr, (bf16_t*)(ws + (l ? W_PP1 : W_PP0)), 256, 1024, 1024, 0);
            }
            prep_misc(PIN(0), PIN(1), (const int*)PIN(2), ws, PP->inv_freq);
        } else if (EN(1) && ph == 1) {
            pg8::Gemm g{xb, (const bf16_t*)(ws + W_IN0), T, 3328, 1024}; pg8::StaticOrder S; S.init(T, 3328, G, bid);
            EpiProj0 E{(bf16_t*)(ws + OFF_PROJ0), (float*)(ws + OFF_GATES), PIN(5), ss0};
            pg8::gemm_phase<EpiProj0, pg8::StaticOrder>(ldsl, g, S, E);
        } else if (EN(2) && ph == 2) {
            mlstm_chunk(lds, (const bf16_t*)(ws + OFF_PROJ0), (const float*)(ws + OFF_GATES), (float*)(ws + OFF_GP), (bf16_t*)(ws + OFF_HG), xb);
        } else if (EN(3) && ph == 3) {
            mlstm_combine((bf16_t*)(ws + OFF_HG), xb, (const bf16_t*)(ws + OFF_PROJ0), PIN(6));
        } else if (EN(4) && (ph == 4 || ph == 15 || ph == 6 || ph == 17)) {
            int phl = ph; asm volatile("" : "+s"(phl));
            const int l = phl > 10; const bool down = (phl == 6 || phl == 17);
            float* ssw = (phl == 4 || phl == 17) ? ss1 : ss0;
            const bf16_t* A = down ? (const bf16_t*)(ws + OFF_HID) : (l ? (const bf16_t*)obuf : (const bf16_t*)(ws + OFF_HG));
            const bf16_t* Bt = down ? (const bf16_t*)(ws + (l ? W_DN1 : W_DN0)) : (const bf16_t*)(ws + (l ? W_OUT1 : W_OUT0));
            pg8::Gemm g{A, Bt, T, 1024, down ? FF : 1024}; pg8::StaticOrder S; S.init(T, 1024, G, bid);
            if (phl == 4) { EpiRes<true> E{(const void*)PIN(0), xb, ssw}; pg8::gemm_phase<EpiRes<true>, pg8::StaticOrder>(ldsl, g, S, E); }
            else { EpiRes<false> E{(const void*)xb, xb, ssw}; pg8::gemm_phase<EpiRes<false>, pg8::StaticOrder>(ldsl, g, S, E); }
            if (EN(11) && down) {
                pg8::Gemm g2{(const bf16_t*)(ws + OFF_PB) + (size_t)l * T * 256, (const bf16_t*)(ws + (l ? W_PP1 : W_PP0)), T, 1024, 256};
                EpiPlain E2{(bf16_t*)(ws + OFF_PPB), 1024};
                pg8::gemm_phase<EpiPlain, pg8::StaticOrder>(ldsl, g2, S, E2);
            }
        } else if (EN(5) && (ph == 5 || ph == 16)) {
            int phl = ph; asm volatile("" : "+s"(phl));
            const int l = phl > 10;
            pg8::Gemm g{xb, (const bf16_t*)(ws + (l ? W_GU1 : W_GU0)), T, 2 * FF, 1024}; pg8::StaticOrder S; S.init(T, 2 * FF, G, bid);
            EpiFfnUp E{(bf16_t*)(ws + OFF_HID), l ? ss0 : ss1};
            pg8::gemm_phase<EpiFfnUp, pg8::StaticOrder>(ldsl, g, S, E);
        } else if (EN(6) && (ph == 7 || ph == 18)) {
            int phl = ph; asm volatile("" : "+s"(phl));
            const int l = phl > 10;
            pg8::Gemm g{xb, (const bf16_t*)(ws + (l ? W_PG1 : W_PG0)), T, 1024, 1024}; pg8::StaticOrder S; S.init(T, 1024, G, bid);
            EpiPle E{xb, l ? xbA : xbB, (const bf16_t*)(ws + OFF_PPB), l ? ss1 : ss0, l ? ss0 : ss1};
            pg8::gemm_phase<EpiPle, pg8::StaticOrder>(ldsl, g, S, E);
        } else if (ph >= 8 && ph <= 14) {
            int phl = ph; asm volatile("" : "+s"(phl));
            const int j = phl - 8;
            bf16_t* const pA0 = (bf16_t*)(ws + OFF_XB), * const pA1 = (bf16_t*)(ws + OFF_XB + 16 * MiB), * const pA2 = (bf16_t*)(ws + OFF_XB + 32 * MiB);
            bf16_t* const pB0 = (bf16_t*)(ws + OFF_PB), * const pB1 = (bf16_t*)(ws + 468 * MiB), * const pB2 = (bf16_t*)(ws + 484 * MiB);
            float* const lA = (float*)(ws + OFF_LSE), * const lB = (float*)(ws + OFF_LSE + MiB);
            const int mb = (j == 2) ? 0 : (j == 3) ? 1 : (j == 5) ? 2 : (j == 6) ? 3 : -1;
            const int ab = (j == 1) ? 0 : (j == 2) ? 1 : (j == 4) ? 2 : (j == 5) ? 3 : -1;
            if (EN(8) && mb >= 0) { const bool sB = mb & 1; attn_merge(sB ? pB0 : pA0, sB ? pB1 : pA1, sB ? pB2 : pA2, sB ? lB : lA, obuf + (size_t)mb * SEQ * D); }
            if (EN(7) && ab >= 0) { const bool sB = ab & 1; __syncthreads();
                attn_phase(lds, (const bf16_t*)(ws + OFF_PROJ1) + (size_t)(ab & 1) * SEQ * 9216, sB ? pB0 : pA0, sB ? pB1 : pA1, sB ? pB2 : pA2, sB ? lB : lA); }
            if (EN(9) && (j == 0 || j == 3)) { const int hf_ = j ? 1 : 0;
                __syncthreads();
                pg8::Gemm g{xb + (size_t)hf_ * 2 * SEQ * D, (const bf16_t*)(ws + W_IN1), 2 * SEQ, 9216, 1024}; pg8::StaticOrder S; S.init(2 * SEQ, 9216, G, bid);
                EpiProj1 E{(bf16_t*)(ws + OFF_PROJ1), ss1, (const float*)(ws + OFF_COS), (const float*)(ws + OFF_SIN), hf_ * 2 * SEQ};
                pg8::gemm_phase<EpiProj1, pg8::StaticOrder>(ldsl, g, S, E);
            }
        } else if (EN(10) && ph == 19) {
            final_norm(outp, xbA, ss0, PIN(17));
        }
        }
        if (ph + 1 < ph_hi) xcd_barrier(xbar);
    }
}

#ifndef N_LAUNCH_MODE
#define N_LAUNCH_MODE 0
#endif
extern "C" void kernel_launch(void* const* d_in, const int* in_sizes, int n_in, void* d_out, int out_size, void* d_ws, size_t ws_size, hipStream_t stream) {
    static int grid = 0;
    if (grid == 0) {
        int dev = 0, cus = 0, per_cu = 0;
        hipGetDevice(&dev); hipDeviceGetAttribute(&cus, hipDeviceAttributeMultiprocessorCount, dev);
        if (hipFuncSetAttribute((const void*)fwd_kernel, hipFuncAttributeMaxDynamicSharedMemorySize, LDS_BYTES) != hipSuccess) { fprintf(stderr, "hipFuncSetAttribute failed\n"); grid = -1; return; }
        if (hipOccupancyMaxActiveBlocksPerMultiprocessor(&per_cu, (const void*)fwd_kernel, NTHREADS, LDS_BYTES) != hipSuccess || per_cu < 1) { fprintf(stderr, "occupancy query: %d\n", per_cu); per_cu = 1; }
        (void)hipGetLastError();
        if (per_cu > 1) per_cu = 1;
        grid = cus * per_cu;
        if (ws_size < WS_END || n_in != 18) { fprintf(stderr, "kernel_launch: ws %zu < %zu or n_in %d\n", ws_size, (size_t)WS_END, n_in); grid = -1; return; }
    }
    if (grid < 0) return;
    if (hipMemsetAsync((unsigned char*)d_ws + OFF_BAR, 0, XCD_BAR_WORDS * 4, stream) != hipSuccess) { fprintf(stderr, "memset failed\n"); return; }
    Params p{};
    for (int i = 0; i < 18; ++i) p.in[i] = (const float*)d_in[i];
    p.out = (float*)d_out; p.ws = (unsigned char*)d_ws; p.repmask = REPMASK; p.pad = 0u;
    for (int i = 0; i < 16; ++i) p.inv_freq[i] = powf(500000.0f, -(float)(2 * i) / 32.0f);
#if N_LAUNCH_MODE == 0
    p.ph_lo = 0; p.ph_hi = NPH;
    void* args[] = {&p};
    hipError_t e = hipLaunchCooperativeKernel((const void*)fwd_kernel, dim3(grid), dim3(NTHREADS), args, LDS_BYTES, stream);
    if (e != hipSuccess) fprintf(stderr, "cooperative launch failed: %s (grid %d)\n", hipGetErrorString(e), grid);
#else
    for (int ph = 0; ph < NPH; ++ph) { p.ph_lo = ph; p.ph_hi = ph + 1; hipLaunchKernelGGL(fwd_kernel, dim3(grid), dim3(NTHREADS), LDS_BYTES, stream, p); }
#endif
}
```

```cpp
#include <hip/hip_runtime.h>
#include <hip/hip_cooperative_groups.h>
#include <cstdio>
#include <cmath>
namespace cg = cooperative_groups;
#include <hip/hip_runtime.h>
namespace pg8 {
#define PG8_LAS __attribute__((address_space(3)))
typedef unsigned short bf16_t;
typedef short bf16x8 __attribute__((ext_vector_type(8)));
typedef float f32x4 __attribute__((ext_vector_type(4)));
typedef unsigned u32x4 __attribute__((ext_vector_type(4)));
constexpr int BM = 256, BK = 64, HALF = 128, HTB = HALF * BK * 2  , STAGE_BYTES = 8 * HTB, NXCD = 8, WGM = 4;

__host__ __device__ __forceinline__ int lds_byte(int r, int c) { const int st = (r >> 4) * 2 + (c >> 5), rr = r & 15, cc = c & 31, ob = rr * 64 + cc * 2; return st * 1024 + (ob ^ (((ob >> 9) & 1) << 5)); }
__host__ __device__ __forceinline__ void stage_rc(int b, int& R, int& C) { const int st = b / 1024, sb = b % 1024, swz = sb ^ (((sb >> 9) & 1) << 5); R = (st >> 1) * 16 + swz / 64; C = (st & 1) * 32 + (swz % 64) / 2; }
__host__ __device__ __forceinline__ int perm32(int rho) { const int n = rho >> 4, i = rho & 15; return 8 * (i >> 2) + 4 * n + (i & 3); }

struct Unit { int pm, pn; };
struct Gemm { const bf16_t* A; const bf16_t* Bt; int M, N, K; };

struct StaticOrder {
    int nM, nN, nwg, G, c;
    __host__ __device__ void init(int M, int N, int G_, int c_) { nM = M / BM; nN = N / BM; nwg = nM * nN; G = G_; c = c_; }
    __host__ __device__ bool next(int i, Unit& u) const {
        const long L = (long)i * G + c; if (L >= nwg) return false;
        int wgid = (int)L; { const int q = nwg / NXCD, r = nwg % NXCD, xcd = wgid % NXCD, off = wgid / NXCD; wgid = (xcd < r ? xcd * (q + 1) : r * (q + 1) + (xcd - r) * q) + off; }
        const int nig = WGM * nN, gid = wgid / nig, fm = gid * WGM, gsz = (nM - fm) < WGM ? (nM - fm) : WGM;
        u.pm = fm + ((wgid % nig) % gsz); u.pn = (wgid % nig) / gsz; return true;
    }
    __device__ __forceinline__ void a_ready(const Unit&) const {}
    __device__ __forceinline__ void done(const Unit&) const {}
};
__device__ __forceinline__ unsigned cvt_pk_bf16(float lo, float hi) { unsigned r; asm volatile("v_cvt_pk_bf16_f32 %0, %1, %2" : "=v"(r) : "v"(lo), "v"(hi)); return r; }
typedef float f32x2 __attribute__((ext_vector_type(2)));
template <class Epi, class Sched>
__device__ __forceinline__ void gemm_phase(PG8_LAS unsigned char* lds, const Gemm g, const Sched& S, const Epi& E) {
    int tid_ = threadIdx.x; asm volatile("" : "+v"(tid_));
    const int tid = tid_, wid = __builtin_amdgcn_readfirstlane(tid >> 6), lane = tid & 63, wr = wid >> 2, wc = wid & 3, fr = lane & 15, fq = lane >> 4;
    const int K = g.K, nt = K / BK;
    unsigned voffA[2], voffB[2];
#pragma unroll
    for (int i = 0; i < 2; ++i) { int R, C; stage_rc(tid * 16 + i * 8192, R, C); const int Rb = Epi::PERM ? ((R & ~31) + perm32(R & 31)) : R;
        voffA[i] = (unsigned)(R * K + C) * 2u; voffB[i] = (unsigned)(Rb * K + C) * 2u; }
    const size_t kstep = (size_t)(BK * 2);
    const size_t hstep = (size_t)HALF * K * 2;
    const size_t tstep = 2 * hstep;
    const unsigned ldsw = (unsigned)wid * 1024u;
    const int aoff = lds_byte(wr * 64 + fr, fq * 8), boff = lds_byte(wc * 32 + fr, fq * 8);
#define PG8_SA(b, h) (((b) * 2 + (h)) * HTB)
#define PG8_SB(b, h) ((4 + (b) * 2 + (h)) * HTB)
#define PG8_STAGE(bufoff, gbase, voff) do { _Pragma("unroll") for (int _i = 0; _i < 2; ++_i) \
        __builtin_amdgcn_global_load_lds((const unsigned*)((const char*)(gbase) + (voff)[_i]), (PG8_LAS unsigned*)(lds + (bufoff) + ldsw + _i * 8192), 16, 0, 0); } while (0)
#define PG8_LDA(dst, b, h) do { _Pragma("unroll") for (int m = 0; m < 4; ++m) _Pragma("unroll") for (int k = 0; k < 2; ++k) dst[m][k] = *(const PG8_LAS bf16x8*)(lds + PG8_SA(b, h) + aoff + m * 2048 + k * 1024); } while (0)
#define PG8_LDB(dst, b, h) do { _Pragma("unroll") for (int n = 0; n < 2; ++n) _Pragma("unroll") for (int k = 0; k < 2; ++k) dst[n][k] = *(const PG8_LAS bf16x8*)(lds + PG8_SB(b, h) + boff + n * 2048 + k * 1024); } while (0)
#define PG8_MMA(ai, bj, At, Bt) do { __builtin_amdgcn_s_setprio(1); _Pragma("unroll") for (int m = 0; m < 4; ++m) _Pragma("unroll") for (int n = 0; n < 2; ++n) _Pragma("unroll") for (int k = 0; k < 2; ++k) \
        acc[ai][bj][m][n] = __builtin_amdgcn_mfma_f32_16x16x32_bf16(Bt[n][k], At[m][k], acc[ai][bj][m][n], 0, 0, 0); __builtin_amdgcn_s_setprio(0); } while (0)
#define PG8_WAIT_V(n) asm volatile("s_waitcnt vmcnt(" #n ")" ::: "memory")
#define PG8_WAIT_L(n) asm volatile("s_waitcnt lgkmcnt(" #n ")" ::: "memory")
#define PG8_BAR __builtin_amdgcn_s_barrier()
#define PG8_SCHED __builtin_amdgcn_sched_barrier(0)
    Unit cur, nxt; int ui = 0;
    if (!S.next(0, cur)) return;
    f32x4 acc[2][2][4][2];
#pragma unroll
    for (int a = 0; a < 2; ++a)
#pragma unroll
        for (int b = 0; b < 2; ++b)
#pragma unroll
            for (int m = 0; m < 4; ++m)
#pragma unroll
                for (int n = 0; n < 2; ++n) acc[a][b][m][n] = (f32x4){0.f, 0.f, 0.f, 0.f};
    bf16x8 At[4][2], B0[2][2], B1[2][2];
    const char* cA = (const char*)g.A + (size_t)cur.pm * tstep; const char* cB = (const char*)g.Bt + (size_t)cur.pn * tstep;
    S.a_ready(cur);
    PG8_STAGE(PG8_SB(0, 0), cB, voffB); PG8_STAGE(PG8_SA(0, 0), cA, voffA); PG8_STAGE(PG8_SB(0, 1), cB + hstep, voffB); PG8_STAGE(PG8_SA(0, 1), cA + hstep, voffA);
    if (wr == 1) PG8_BAR;
    PG8_WAIT_V(4); PG8_BAR;
    PG8_STAGE(PG8_SB(1, 0), cB + kstep, voffB); PG8_STAGE(PG8_SA(1, 0), cA + kstep, voffA); PG8_STAGE(PG8_SB(1, 1), cB + hstep + kstep, voffB);
    PG8_WAIT_V(6); PG8_BAR;
    for (;;) {
        const bool has_next = S.next(ui + 1, nxt);
        const char* nA = has_next ? (const char*)g.A + (size_t)nxt.pm * tstep : cA; const char* nB = has_next ? (const char*)g.Bt + (size_t)nxt.pn * tstep : cB;
        for (int t = 0; t < nt; t += 2) {
            const bool last = (t == nt - 2);
            const char* a1 = cA + (size_t)(t + 1) * kstep;
            const char* a2 = last ? nA : cA + (size_t)(t + 2) * kstep; const char* b2 = last ? nB : cB + (size_t)(t + 2) * kstep;
            const char* a3 = a2 + kstep; const char* b3 = b2 + kstep;
            if (last && has_next) S.a_ready(nxt);
            PG8_LDB(B0, 0, 0); PG8_SCHED; PG8_LDA(At, 0, 0); PG8_STAGE(PG8_SA(1, 1), a1 + hstep, voffA);
            PG8_WAIT_L(8); PG8_BAR; PG8_WAIT_L(0); PG8_MMA(0, 0, At, B0); PG8_BAR; PG8_SCHED;
            PG8_LDB(B1, 0, 1); PG8_STAGE(PG8_SB(0, 0), b2, voffB);
            PG8_BAR; PG8_WAIT_L(0); PG8_MMA(0, 1, At, B1); PG8_BAR;
            PG8_LDA(At, 0, 1); PG8_STAGE(PG8_SA(0, 0), a2, voffA);
            PG8_BAR; PG8_WAIT_L(0); PG8_MMA(1, 0, At, B0); PG8_BAR; PG8_SCHED;
            PG8_STAGE(PG8_SB(0, 1), b2 + hstep, voffB);
            PG8_WAIT_V(6); PG8_BAR; PG8_MMA(1, 1, At, B1); PG8_BAR;
            PG8_LDB(B0, 1, 0); PG8_SCHED; PG8_LDA(At, 1, 0); PG8_STAGE(PG8_SA(0, 1), a2 + hstep, voffA);
            PG8_WAIT_L(8); PG8_BAR; PG8_WAIT_L(0); PG8_MMA(0, 0, At, B0); PG8_BAR; PG8_SCHED;
            PG8_LDB(B1, 1, 1); PG8_STAGE(PG8_SB(1, 0), b3, voffB);
            PG8_BAR; PG8_WAIT_L(0); PG8_MMA(0, 1, At, B1); PG8_BAR;
            PG8_LDA(At, 1, 1); PG8_STAGE(PG8_SA(1, 0), a3, voffA);
            PG8_BAR; PG8_WAIT_L(0); PG8_MMA(1, 0, At, B0); PG8_BAR; PG8_SCHED;
            PG8_STAGE(PG8_SB(1, 1), b3 + hstep, voffB);
            PG8_WAIT_V(6); PG8_BAR; PG8_MMA(1, 1, At, B1); PG8_BAR;
        }
        if constexpr (!Epi::AFTER_DRAIN) { E(acc, cur, wr, wc, fr, fq); S.done(cur); }
        if (!has_next) break;
#pragma unroll
        for (int a = 0; a < 2; ++a)
#pragma unroll
            for (int b = 0; b < 2; ++b)
#pragma unroll
                for (int m = 0; m < 4; ++m)
#pragma unroll
                    for (int n = 0; n < 2; ++n) acc[a][b][m][n] = (f32x4){0.f, 0.f, 0.f, 0.f};
        cur = nxt; cA = nA; cB = nB; ++ui;
    }
    PG8_WAIT_V(0);
    if (wr == 0) PG8_BAR;
    PG8_BAR;
    if constexpr (Epi::AFTER_DRAIN) { E.fused(acc, cur, wr, wc, fr, fq, lds, wid, lane); S.done(cur); }
#undef PG8_SA
#undef PG8_SB
#undef PG8_STAGE
#undef PG8_LDA
#undef PG8_LDB
#undef PG8_MMA
#undef PG8_WAIT_V
#undef PG8_WAIT_L
#undef PG8_BAR
#undef PG8_SCHED
}
}
#define LAS __attribute__((address_space(3)))
#define XB_TMO      128
#define XB_XCNT(j)  (256  + 64 * (j))
#define XB_XSUB(j)  (1280 + 64 * (j))
#define XB_XGEN(j)  (2304 + 64 * (j))
#define XB_TOP      3328
#define XB_TOPGEN   3392
#define XCD_BAR_WORDS 3456
#define XB_SPIN_CAP (1u << 18)

__device__ __forceinline__ unsigned xb_ld(unsigned* p)              { return __hip_atomic_load(p, __ATOMIC_RELAXED, __HIP_MEMORY_SCOPE_AGENT); }
__device__ __forceinline__ unsigned xb_add(unsigned* p, unsigned v) { return __hip_atomic_fetch_add(p, v, __ATOMIC_RELAXED, __HIP_MEMORY_SCOPE_AGENT); }
__device__ __forceinline__ unsigned xb_xcc_id() { return (unsigned)__builtin_amdgcn_s_getreg((3 << 11) | 20) & 0xFu; }
#define XB_SPIN(cond, bar) do { unsigned _sp = 0; while (cond) { __builtin_amdgcn_s_sleep(1); \
    if ((++_sp & 255u) == 0u) { if (xb_ld(&(bar)[XB_TMO])) break; if (_sp > XB_SPIN_CAP) { atomicAdd(&(bar)[XB_TMO], 1u); break; } } } } while (0)

struct XcdBarrier {
    unsigned* bar; unsigned x;
    volatile LAS unsigned* st;
};

__device__ __forceinline__ XcdBarrier xcd_barrier_post(unsigned* bar, volatile LAS unsigned* st) {
    XcdBarrier b; b.bar = bar; b.x = xb_xcc_id(); b.st = st;
    if (threadIdx.x == 0) (void)xb_add(&bar[XB_XCNT(b.x)], 1u);
    return b;
}
__device__ __forceinline__ void xcd_barrier_complete(unsigned* bar, unsigned x, unsigned& nloc, unsigned& nx) {
    const unsigned G = gridDim.x * gridDim.y * gridDim.z;
    unsigned sum, cnt, mine, sp = 0u;
    for (;;) {
        sum = 0u; cnt = 0u; mine = 0u;
#pragma unroll
        for (unsigned j = 0; j < 16; ++j) { const unsigned c = xb_ld(&bar[XB_XCNT(j)]); sum += c; cnt += (c > 0u) ? 1u : 0u; mine = (j == x) ? c : mine; }
        if (sum == G) break;
        __builtin_amdgcn_s_sleep(1);
        if ((++sp & 255u) == 0u) { if (xb_ld(&bar[XB_TMO])) break; if (sp > XB_SPIN_CAP) { atomicAdd(&bar[XB_TMO], 1u); break; } }
    }
    nloc = mine > 0u ? mine : 1u; nx = cnt > 0u ? cnt : 1u;
}

__device__ __forceinline__ void xcd_barrier(const XcdBarrier& b) {
    asm volatile("s_waitcnt vmcnt(0)" ::: "memory");
    __syncthreads();
    if (threadIdx.x == 0) {
        unsigned* bar = b.bar;
        __builtin_amdgcn_s_waitcnt(0);
        unsigned nloc = b.st[0], nx = b.st[1];
        if (nloc == 0u) { xcd_barrier_complete(bar, b.x, nloc, nx); b.st[0] = nloc; b.st[1] = nx; }
        const unsigned old = xb_add(&bar[XB_XSUB(b.x)], 1u);
        const unsigned gen = old / nloc;
        if (old + 1u == (gen + 1u) * nloc) {
            __builtin_amdgcn_fence(__ATOMIC_RELEASE, "agent");
            asm volatile("s_waitcnt vmcnt(0)" ::: "memory");
            const unsigned og = xb_add(&bar[XB_TOP], 1u);
            const unsigned tg = og / nx;
            if (og + 1u == (tg + 1u) * nx) xb_add(&bar[XB_TOPGEN], 1u);
            else XB_SPIN(xb_ld(&bar[XB_TOPGEN]) == tg, bar);
            __builtin_amdgcn_fence(__ATOMIC_ACQUIRE, "agent");
            xb_add(&bar[XB_XGEN(b.x)], 1u);
            asm volatile("s_waitcnt vmcnt(0)" ::: "memory");
        } else {
            XB_SPIN(xb_ld(&bar[XB_XGEN(b.x)]) == gen, bar);
            __builtin_amdgcn_fence(__ATOMIC_ACQUIRE, "agent");
            asm volatile("s_waitcnt vmcnt(0)" ::: "memory");
        }
    }
    __syncthreads();
}

using pg8::bf16_t; using pg8::bf16x8; using pg8::f32x4; using pg8::u32x4; using pg8::Unit;
typedef unsigned u32x2 __attribute__((ext_vector_type(2)));
typedef short s16x4 __attribute__((ext_vector_type(4)));
typedef float f32x2v __attribute__((ext_vector_type(2)));
typedef __bf16 bf16v2 __attribute__((ext_vector_type(2)));
#define DI __device__ __forceinline__

constexpr int T = 32768, SEQ = 8192, D = 1024, FF = 2816;
constexpr int NTHREADS = 512;
constexpr int LDS_MAIN = 147456, LDS_BYTES = LDS_MAIN + 16;
constexpr size_t MiB = (size_t)1 << 20;
constexpr size_t W_IN0 = 0, W_OUT0 = 7 * MiB, W_IN1 = 9 * MiB, W_OUT1 = 27 * MiB, W_GU0 = 29 * MiB, W_GU1 = 40 * MiB, W_DN0 = 51 * MiB, W_DN1 = 57 * MiB,
                 W_PG0 = 63 * MiB, W_PG1 = 65 * MiB, W_PP0 = 67 * MiB, W_PP1 = 67 * MiB + MiB / 2;
constexpr size_t OFF_XB = 68 * MiB, OFF_PB = 132 * MiB, OFF_SS0 = 164 * MiB, OFF_SS1 = 166 * MiB, OFF_COS = 168 * MiB, OFF_SIN = 170 * MiB, OFF_GATES = 172 * MiB, OFF_LSE = 176 * MiB, OFF_BAR = 178 * MiB;
constexpr size_t OFF_R = 180 * MiB, OFF_PROJ0 = OFF_R, OFF_HG = OFF_R + 192 * MiB, OFF_HID = OFF_R, OFF_PPB = OFF_R + 192 * MiB, OFF_PROJ1 = OFF_R, OFF_OG = OFF_XB;
constexpr size_t OFF_GP = 436 * MiB;
constexpr size_t WS_END = 500 * MiB;
constexpr int NPH = 20;

struct Params { const float* in[18]; float* out; unsigned char* ws; float inv_freq[16]; int ph_lo, ph_hi; unsigned repmask, pad; };

DI unsigned pk2(float lo, float hi) { f32x2v v = {lo, hi}; bf16v2 b = __builtin_convertvector(v, bf16v2); return __builtin_bit_cast(unsigned, b); }
DI float bflo(unsigned w) { return __uint_as_float(w << 16); }
DI float bfhi(unsigned w) { return __uint_as_float(w & 0xffff0000u); }
DI float sigmoidf_(float x) { return __builtin_amdgcn_rcpf(1.0f + __expf(-x)); }
DI float row_rs(const float* ss, int row) {
    const f32x4* p = (const f32x4*)(ss + (size_t)row * 16);
    const f32x4 a = p[0], b = p[1], c = p[2], d = p[3]; const f32x4 s = (a + b) + (c + d);
    return rsqrtf(((s[0] + s[1]) + (s[2] + s[3])) * (1.0f / 1024.0f) + 1e-6f);
}

DI f32x4 ss_ld(const float* ss, int row, int fq) { return *(const f32x4*)(ss + (size_t)row * 16 + 4 * fq); }
DI float ss_rs(const f32x4 v) { float s = (v[0] + v[1]) + (v[2] + v[3]); s += __shfl_xor(s, 16); s += __shfl_xor(s, 32); return rsqrtf(s * (1.0f / 1024.0f) + 1e-6f); }

struct EpiProj0 {
    static constexpr bool PERM = true, AFTER_DRAIN = false;
    bf16_t* O; float* gates; const float* gbias; const float* ss;
    DI void operator()(const f32x4 (&acc)[2][2][4][2], const Unit& u, int wr, int wc, int fr, int fq) const {
        const int row0 = u.pm * 256 + wr * 64 + fr;
        f32x4 sva[2][4]; float rsa[2][4];
#pragma unroll
        for (int ai = 0; ai < 2; ++ai)
#pragma unroll
            for (int m = 0; m < 4; ++m) sva[ai][m] = ss_ld(ss, row0 + ai * 128 + m * 16, fq);
#pragma unroll
        for (int ai = 0; ai < 2; ++ai)
#pragma unroll
            for (int m = 0; m < 4; ++m) rsa[ai][m] = ss_rs(sva[ai][m]);
#pragma unroll
        for (int ai = 0; ai < 2; ++ai) { const float (&rs)[4] = rsa[ai];
            if (u.pn < 12) { const int col0 = u.pn * 256 + wc * 32 + 8 * fq;
#pragma unroll
                for (int m = 0; m < 4; ++m) { bf16_t* rowp = O + (size_t)(row0 + ai * 128 + m * 16) * 3072 + col0;
#pragma unroll
                    for (int bj = 0; bj < 2; ++bj) { const f32x4 v0 = acc[ai][bj][m][0] * rs[m], v1 = acc[ai][bj][m][1] * rs[m];
                        u32x4 w; w.x = pk2(v0[0], v0[1]); w.y = pk2(v0[2], v0[3]); w.z = pk2(v1[0], v1[1]); w.w = pk2(v1[2], v1[3]);
                        *(u32x4*)(rowp + bj * 128) = w; } }
            } else if (wc == 0) {
#pragma unroll
                for (int m = 0; m < 4; ++m)
#pragma unroll
                    for (int n = 0; n < 2; ++n) { const f32x4 bv = *(const f32x4*)(gbias + 8 * fq + 4 * n);
                        *(f32x4*)(gates + (size_t)(row0 + ai * 128 + m * 16) * 32 + 8 * fq + 4 * n) = acc[ai][0][m][n] * rs[m] + bv; }
            }
        }
    }
};
template <bool HF32> struct EpiRes {
    static constexpr bool PERM = true, AFTER_DRAIN = false;
    const void* hin; bf16_t* xout; float* ssw;
    DI void operator()(const f32x4 (&acc)[2][2][4][2], const Unit& u, int wr, int wc, int fr, int fq) const {
        const int row0 = u.pm * 256 + wr * 64 + fr, col0 = u.pn * 256 + wc * 32 + 8 * fq;
#pragma unroll
        for (int ai = 0; ai < 2; ++ai) {
            if (HF32) {
#pragma unroll
                for (int mh = 0; mh < 4; mh += 2) { f32x4 hv[2][2][2];
#pragma unroll
                    for (int m = 0; m < 2; ++m)
#pragma unroll
                        for (int bj = 0; bj < 2; ++bj)
#pragma unroll
                            for (int n = 0; n < 2; ++n) hv[m][bj][n] = *(const f32x4*)((const float*)hin + (size_t)(row0 + ai * 128 + (mh + m) * 16) * D + col0 + bj * 128 + n * 4);
#pragma unroll
                    for (int m = 0; m < 2; ++m) { const int row = row0 + ai * 128 + (mh + m) * 16; float sq = 0.f;
#pragma unroll
                        for (int bj = 0; bj < 2; ++bj) { const f32x4 o0 = hv[m][bj][0] + acc[ai][bj][mh + m][0], o1 = hv[m][bj][1] + acc[ai][bj][mh + m][1];
                            u32x4 w; w.x = pk2(o0[0], o0[1]); w.y = pk2(o0[2], o0[3]); w.z = pk2(o1[0], o1[1]); w.w = pk2(o1[2], o1[3]); *(u32x4*)(xout + (size_t)row * D + col0 + bj * 128) = w;
#pragma unroll
                            for (int j = 0; j < 4; ++j) { const float r0 = bflo(w[j]), r1 = bfhi(w[j]); sq += r0 * r0 + r1 * r1; } }
                        sq += __shfl_xor(sq, 16); sq += __shfl_xor(sq, 32);
                        if (fq == 0) ssw[(size_t)row * 16 + u.pn * 4 + wc] = sq; }
                    asm volatile("" ::: "memory"); }
            } else { u32x4 hv[4][2];
#pragma unroll
                for (int m = 0; m < 4; ++m)
#pragma unroll
                    for (int bj = 0; bj < 2; ++bj) hv[m][bj] = *(const u32x4*)((const bf16_t*)hin + (size_t)(row0 + ai * 128 + m * 16) * D + col0 + bj * 128);
#pragma unroll
                for (int m = 0; m < 4; ++m) { const int row = row0 + ai * 128 + m * 16; float sq = 0.f;
#pragma unroll
                    for (int bj = 0; bj < 2; ++bj) { const u32x4 hw = hv[m][bj];
                        const f32x4 o0 = f32x4{bflo(hw.x), bfhi(hw.x), bflo(hw.y), bfhi(hw.y)} + acc[ai][bj][m][0], o1 = f32x4{bflo(hw.z), bfhi(hw.z), bflo(hw.w), bfhi(hw.w)} + acc[ai][bj][m][1];
                        u32x4 w; w.x = pk2(o0[0], o0[1]); w.y = pk2(o0[2], o0[3]); w.z = pk2(o1[0], o1[1]); w.w = pk2(o1[2], o1[3]); *(u32x4*)(xout + (size_t)row * D + col0 + bj * 128) = w;
#pragma unroll
                        for (int j = 0; j < 4; ++j) { const float r0 = bflo(w[j]), r1 = bfhi(w[j]); sq += r0 * r0 + r1 * r1; } }
                    sq += __shfl_xor(sq, 16); sq += __shfl_xor(sq, 32);
                    if (fq == 0) ssw[(size_t)row * 16 + u.pn * 4 + wc] = sq; }
                asm volatile("" ::: "memory"); }
        }
    }
};
struct EpiFfnUp {
    static constexpr bool PERM = true, AFTER_DRAIN = false;
    bf16_t* hid; const float* ss;
    DI void operator()(const f32x4 (&acc)[2][2][4][2], const Unit& u, int wr, int wc, int fr, int fq) const {
        const int row0 = u.pm * 256 + wr * 64 + fr, col0 = u.pn * 128 + wc * 32 + 8 * fq;
        f32x4 sva[2][4]; float rsa[2][4];
#pragma unroll
        for (int ai = 0; ai < 2; ++ai)
#pragma unroll
            for (int m = 0; m < 4; ++m) sva[ai][m] = ss_ld(ss, row0 + ai * 128 + m * 16, fq);
#pragma unroll
        for (int ai = 0; ai < 2; ++ai)
#pragma unroll
            for (int m = 0; m < 4; ++m) rsa[ai][m] = ss_rs(sva[ai][m]);
#pragma unroll
        for (int ai = 0; ai < 2; ++ai) { const float (&rs)[4] = rsa[ai];
#pragma unroll
            for (int m = 0; m < 4; ++m) { unsigned wv[4];
#pragma unroll
                for (int n = 0; n < 2; ++n) { const f32x4 g = acc[ai][0][m][n] * rs[m], up = acc[ai][1][m][n] * rs[m]; f32x4 h;
#pragma unroll
                    for (int j = 0; j < 4; ++j) h[j] = g[j] * sigmoidf_(g[j]) * up[j];
                    wv[2 * n] = pk2(h[0], h[1]); wv[2 * n + 1] = pk2(h[2], h[3]); }
                u32x4 w; w.x = wv[0]; w.y = wv[1]; w.z = wv[2]; w.w = wv[3];
                *(u32x4*)(hid + (size_t)(row0 + ai * 128 + m * 16) * FF + col0) = w; } }
    }
};
struct EpiPlain {
    static constexpr bool PERM = true, AFTER_DRAIN = false;
    bf16_t* O; int ldc;
    DI void operator()(const f32x4 (&acc)[2][2][4][2], const Unit& u, int wr, int wc, int fr, int fq) const {
        const int row0 = u.pm * 256 + wr * 64 + fr, col0 = u.pn * 256 + wc * 32 + 8 * fq;
#pragma unroll
        for (int ai = 0; ai < 2; ++ai)
#pragma unroll
            for (int m = 0; m < 4; ++m) { bf16_t* rowp = O + (size_t)(row0 + ai * 128 + m * 16) * ldc + col0;
#pragma unroll
                for (int bj = 0; bj < 2; ++bj) { const f32x4 v0 = acc[ai][bj][m][0], v1 = acc[ai][bj][m][1];
                    u32x4 w; w.x = pk2(v0[0], v0[1]); w.y = pk2(v0[2], v0[3]); w.z = pk2(v1[0], v1[1]); w.w = pk2(v1[2], v1[3]);
                    *(u32x4*)(rowp + bj * 128) = w; } }
    }
};
struct EpiPle {
    static constexpr bool PERM = true, AFTER_DRAIN = false;
    const bf16_t* xin; bf16_t* xout; const bf16_t* pp; const float* ss; float* ssw;
    DI void operator()(const f32x4 (&acc)[2][2][4][2], const Unit& u, int wr, int wc, int fr, int fq) const {
        const int row0 = u.pm * 256 + wr * 64 + fr, col0 = u.pn * 256 + wc * 32 + 8 * fq;
#pragma unroll
        for (int ai = 0; ai < 2; ++ai)
#pragma unroll
            for (int mh = 0; mh < 4; mh += 2) { f32x4 sv[2]; u32x4 hv[2][2], pv[2][2]; float rs[2];
#pragma unroll
                for (int m = 0; m < 2; ++m) { sv[m] = ss_ld(ss, row0 + ai * 128 + (mh + m) * 16, fq);
#pragma unroll
                    for (int bj = 0; bj < 2; ++bj) { const size_t o2 = (size_t)(row0 + ai * 128 + (mh + m) * 16) * D + col0 + bj * 128; hv[m][bj] = *(const u32x4*)(xin + o2); pv[m][bj] = *(const u32x4*)(pp + o2); } }
#pragma unroll
                for (int m = 0; m < 2; ++m) rs[m] = ss_rs(sv[m]);
#pragma unroll
                for (int m = 0; m < 2; ++m) { const int row = row0 + ai * 128 + (mh + m) * 16; float sq = 0.f;
#pragma unroll
                    for (int bj = 0; bj < 2; ++bj) { const f32x4 a0 = acc[ai][bj][mh + m][0] * rs[m], a1 = acc[ai][bj][mh + m][1] * rs[m]; const u32x4 pw = pv[m][bj], hw = hv[m][bj]; f32x4 o0, o1;
                        o0[0] = bflo(hw.x) + sigmoidf_(a0[0]) * bflo(pw.x); o0[1] = bfhi(hw.x) + sigmoidf_(a0[1]) * bfhi(pw.x); o0[2] = bflo(hw.y) + sigmoidf_(a0[2]) * bflo(pw.y); o0[3] = bfhi(hw.y) + sigmoidf_(a0[3]) * bfhi(pw.y);
                        o1[0] = bflo(hw.z) + sigmoidf_(a1[0]) * bflo(pw.z); o1[1] = bfhi(hw.z) + sigmoidf_(a1[1]) * bfhi(pw.z); o1[2] = bflo(hw.w) + sigmoidf_(a1[2]) * bflo(pw.w); o1[3] = bfhi(hw.w) + sigmoidf_(a1[3]) * bfhi(pw.w);
                        u32x4 w; w.x = pk2(o0[0], o0[1]); w.y = pk2(o0[2], o0[3]); w.z = pk2(o1[0], o1[1]); w.w = pk2(o1[2], o1[3]); *(u32x4*)(xout + (size_t)row * D + col0 + bj * 128) = w;
#pragma unroll
                        for (int j = 0; j < 4; ++j) { const float r0 = bflo(w[j]), r1 = bfhi(w[j]); sq += r0 * r0 + r1 * r1; } }
                    sq += __shfl_xor(sq, 16); sq += __shfl_xor(sq, 32);
                    if (fq == 0) ssw[(size_t)row * 16 + u.pn * 4 + wc] = sq; }
                asm volatile("" ::: "memory"); }
    }
};
struct EpiProj1 {
    static constexpr bool PERM = true, AFTER_DRAIN = false;
    bf16_t* O; const float* ss; const float* cs; const float* sn; int rowbase;
    DI void operator()(const f32x4 (&acc)[2][2][4][2], const Unit& u, int wr, int wc, int fr, int fq) const {
        const int row0 = u.pm * 256 + wr * 64 + fr, col0 = u.pn * 256 + wc * 32 + 8 * fq;
        const bool rope = (((u.pn >> 2) % 3) < 2) && (wc == 0);
#pragma unroll
        for (int ai = 0; ai < 2; ++ai) { f32x4 sv[4]; float rs[4];
#pragma unroll
            for (int m = 0; m < 4; ++m) sv[m] = ss_ld(ss, rowbase + row0 + ai * 128 + m * 16, fq);
#pragma unroll
            for (int m = 0; m < 4; ++m) rs[m] = ss_rs(sv[m]);
            if (rope) {
#pragma unroll
                for (int mh = 0; mh < 4; mh += 2) { f32x4 c4[2], s4[2];
#pragma unroll
                    for (int m = 0; m < 2; ++m) { const int grow = rowbase + row0 + ai * 128 + (mh + m) * 16; c4[m] = *(const f32x4*)(cs + (size_t)grow * 16 + 4 * fq); s4[m] = *(const f32x4*)(sn + (size_t)grow * 16 + 4 * fq); }
#pragma unroll
                    for (int m = 0; m < 2; ++m) { bf16_t* rowp = O + (size_t)(row0 + ai * 128 + (mh + m) * 16) * 9216 + col0; const f32x4 c = c4[m], s = s4[m];
#pragma unroll
                        for (int bj = 0; bj < 2; ++bj) { const f32x4 v0 = acc[ai][bj][mh + m][0] * rs[mh + m], v1 = acc[ai][bj][mh + m][1] * rs[mh + m]; f32x4 r0, r1;
                            r0[0] = v0[0] * c[0] - v0[1] * s[0]; r0[1] = v0[1] * c[0] + v0[0] * s[0]; r0[2] = v0[2] * c[1] - v0[3] * s[1]; r0[3] = v0[3] * c[1] + v0[2] * s[1];
                            r1[0] = v1[0] * c[2] - v1[1] * s[2]; r1[1] = v1[1] * c[2] + v1[0] * s[2]; r1[2] = v1[2] * c[3] - v1[3] * s[3]; r1[3] = v1[3] * c[3] + v1[2] * s[3];
                            u32x4 w; w.x = pk2(r0[0], r0[1]); w.y = pk2(r0[2], r0[3]); w.z = pk2(r1[0], r1[1]); w.w = pk2(r1[2], r1[3]);
                            *(u32x4*)(rowp + bj * 128) = w; } } }
            } else {
#pragma unroll
                for (int m = 0; m < 4; ++m) { bf16_t* rowp = O + (size_t)(row0 + ai * 128 + m * 16) * 9216 + col0;
#pragma unroll
                    for (int bj = 0; bj < 2; ++bj) { const f32x4 v0 = acc[ai][bj][m][0] * rs[m], v1 = acc[ai][bj][m][1] * rs[m];
                        u32x4 w; w.x = pk2(v0[0], v0[1]); w.y = pk2(v0[2], v0[3]); w.z = pk2(v1[0], v1[1]); w.w = pk2(v1[2], v1[3]);
                        *(u32x4*)(rowp + bj * 128) = w; } }
            }
        }
    }
};

__device__ void prep_weight(LAS float* tile, const float* s0, const float* s1, const float* nrm, bf16_t* dst, int K, int Nsrc, int Ndst, int kind) {
    int tid_ = threadIdx.x; asm volatile("" : "+v"(tid_));
    const int tid = tid_; const int nkt = K / 64, ntiles = nkt * (Ndst / 64);
    LAS float* const tile_base = tile; int tb = 0;
    __syncthreads();
    for (int tl0 = blockIdx.x; tl0 < ntiles; tl0 += 4 * gridDim.x, tb ^= 1) {
#pragma unroll
        for (int u = 0; u < 4; ++u) { const int tl = tl0 + u * gridDim.x; if (tl >= ntiles) break;
            LAS float* tl_ = tile_base + (tb * 4 + u) * (64 * 65);
            const int n0 = (tl / nkt) * 64, k0 = (tl % nkt) * 64;
            const bool scalar_path = (kind == 2) && (((n0 >> 10) % 3) < 2) && ((n0 & 127) == 0);
            if (!scalar_path) { const int g4 = (tid & 15) * 4, n = n0 + g4; const float* src = s0; int col = n; float sc = 1.f; bool valid = true;
                if (kind == 1) { valid = n < 3104; if (n < 512) sc = 0.125f; }
                else if (kind == 3) { const int t = n >> 8, half = (n >> 7) & 1, j = n & 127; col = t * 128 + j; if (half) src = s1; }
#pragma unroll
                for (int i = 0; i < 2; ++i) { const int kl = (tid >> 4) + 32 * i; f32x4 v = {0.f, 0.f, 0.f, 0.f};
                    if (valid) { v = *(const f32x4*)(src + (size_t)(k0 + kl) * Nsrc + col) * sc; if (nrm) v *= nrm[k0 + kl]; }
                    tl_[kl * 65 + g4] = v[0]; tl_[kl * 65 + g4 + 1] = v[1]; tl_[kl * 65 + g4 + 2] = v[2]; tl_[kl * 65 + g4 + 3] = v[3]; }
            } else { const int nl = tid & 63, n = n0 + nl, d = n & 127; const int col = (d < 32) ? n - d + ((d & 1) ? 16 + (d >> 1) : (d >> 1)) : n;
#pragma unroll
                for (int i = 0; i < 8; ++i) { const int kl = (tid >> 6) + 8 * i; float v = s0[(size_t)(k0 + kl) * Nsrc + col]; if (nrm) v *= nrm[k0 + kl];
                    tl_[kl * 65 + nl] = v; } } }
        __syncthreads();
#pragma unroll
        for (int u = 0; u < 4; ++u) { const int tl = tl0 + u * gridDim.x; if (tl >= ntiles) break;
            const LAS float* tl_ = tile_base + (tb * 4 + u) * (64 * 65);
            const int n0 = (tl / nkt) * 64, k0 = (tl % nkt) * 64;
            const int nl = tid >> 3, ks = (tid & 7) * 8; float v[8];
#pragma unroll
            for (int j = 0; j < 8; ++j) v[j] = tl_[(ks + j) * 65 + nl];
            u32x4 w; w.x = pk2(v[0], v[1]); w.y = pk2(v[2], v[3]); w.z = pk2(v[4], v[5]); w.w = pk2(v[6], v[7]);
            *(u32x4*)(dst + (size_t)(n0 + nl) * K + k0 + ks) = w; }
    }
}
__device__ void prep_misc(const float* in_x, const float* in_p, const int* in_pos, unsigned char* ws, const __attribute__((address_space(4))) float* inv_freq_tab) {
    int tid_ = threadIdx.x; asm volatile("" : "+v"(tid_));
    const int tid = tid_, lane = tid & 63, wv = tid >> 6;
    { const float* x = in_x; bf16_t* xb = (bf16_t*)(ws + OFF_XB); float* ss = (float*)(ws + OFF_SS0);
      for (int row0 = (blockIdx.x * 8 + wv) * 4; row0 < T; row0 += gridDim.x * 32) { f32x4 v[4][2][2];
#pragma unroll
          for (int r = 0; r < 4; ++r)
#pragma unroll
              for (int i = 0; i < 2; ++i) { const float* q = x + (size_t)(row0 + r) * D + (i * 64 + lane) * 8; v[r][i][0] = *(const f32x4*)q; v[r][i][1] = *(const f32x4*)(q + 4); }
#pragma unroll
          for (int r = 0; r < 4; ++r) { float sq = 0.f;
#pragma unroll
              for (int i = 0; i < 2; ++i) { const f32x4 t0 = v[r][i][0], t1 = v[r][i][1];
                  sq += ((t0[0] * t0[0] + t0[1] * t0[1]) + (t0[2] * t0[2] + t0[3] * t0[3])) + ((t1[0] * t1[0] + t1[1] * t1[1]) + (t1[2] * t1[2] + t1[3] * t1[3]));
                  u32x4 w; w.x = pk2(t0[0], t0[1]); w.y = pk2(t0[2], t0[3]); w.z = pk2(t1[0], t1[1]); w.w = pk2(t1[2], t1[3]); *(u32x4*)(xb + (size_t)(row0 + r) * D + (i * 64 + lane) * 8) = w; }
#pragma unroll
              for (int o = 32; o >= 1; o >>= 1) sq += __shfl_xor(sq, o);
              if (lane < 16) ss[(size_t)(row0 + r) * 16 + lane] = (lane == 0) ? sq : 0.f; } } }
    { const float* p = in_p; bf16_t* pb = (bf16_t*)(ws + OFF_PB); const size_t n8 = (size_t)2 * T * 256 / 8, stride = (size_t)gridDim.x * NTHREADS;
      for (size_t i = (size_t)blockIdx.x * NTHREADS + tid; i < n8; i += 4 * stride) { f32x4 v[4][2];
#pragma unroll
          for (int r = 0; r < 4; ++r) if (i + r * stride < n8) { v[r][0] = *(const f32x4*)(p + (i + r * stride) * 8); v[r][1] = *(const f32x4*)(p + (i + r * stride) * 8 + 4); }
#pragma unroll
          for (int r = 0; r < 4; ++r) if (i + r * stride < n8) { u32x4 w; w.x = pk2(v[r][0][0], v[r][0][1]); w.y = pk2(v[r][0][2], v[r][0][3]); w.z = pk2(v[r][1][0], v[r][1][1]); w.w = pk2(v[r][1][2], v[r][1][3]); *(u32x4*)(pb + (i + r * stride) * 8) = w; } } }
    { const int* pos = in_pos; float* cs = (float*)(ws + OFF_COS); float* sn = (float*)(ws + OFF_SIN);
      for (int i = blockIdx.x * NTHREADS + tid; i < T * 16; i += gridDim.x * NTHREADS) { const float ang = (float)pos[i >> 4] * inv_freq_tab[i & 15];
          const double rev = (double)ang * 0.15915494309189535; const float fr = (float)(rev - rint(rev));
          cs[i] = __builtin_amdgcn_cosf(fr); sn[i] = __builtin_amdgcn_sinf(fr); } }
}

DI bf16x8 tr_read2(unsigned a_lo, unsigned a_hi) {
    s16x4 lo, hi;
    asm volatile("ds_read_b64_tr_b16 %0, %2\n\tds_read_b64_tr_b16 %1, %3\n\ts_waitcnt lgkmcnt(0)" : "=&v"(lo), "=&v"(hi) : "v"(a_lo), "v"(a_hi) : "memory");
    return __builtin_shufflevector(lo, hi, 0, 1, 2, 3, 4, 5, 6, 7);
}
DI void tr_read8(unsigned a0, unsigned a1, unsigned a2, unsigned a3, unsigned a4, unsigned a5, unsigned a6, unsigned a7, bf16x8& r0, bf16x8& r1, bf16x8& r2, bf16x8& r3) {
    s16x4 t0, t1, t2, t3, t4, t5, t6, t7;
    asm volatile("ds_read_b64_tr_b16 %0, %8\n\tds_read_b64_tr_b16 %1, %9\n\tds_read_b64_tr_b16 %2, %10\n\tds_read_b64_tr_b16 %3, %11\n\t"
                 "ds_read_b64_tr_b16 %4, %12\n\tds_read_b64_tr_b16 %5, %13\n\tds_read_b64_tr_b16 %6, %14\n\tds_read_b64_tr_b16 %7, %15\n\ts_waitcnt lgkmcnt(0)"
                 : "=&v"(t0), "=&v"(t1), "=&v"(t2), "=&v"(t3), "=&v"(t4), "=&v"(t5), "=&v"(t6), "=&v"(t7)
                 : "v"(a0), "v"(a1), "v"(a2), "v"(a3), "v"(a4), "v"(a5), "v"(a6), "v"(a7) : "memory");
    r0 = __builtin_shufflevector(t0, t1, 0, 1, 2, 3, 4, 5, 6, 7); r1 = __builtin_shufflevector(t2, t3, 0, 1, 2, 3, 4, 5, 6, 7);
    r2 = __builtin_shufflevector(t4, t5, 0, 1, 2, 3, 4, 5, 6, 7); r3 = __builtin_shufflevector(t6, t7, 0, 1, 2, 3, 4, 5, 6, 7);
}
DI s16x4 tr_read1(unsigned a) { s16x4 r; asm volatile("ds_read_b64_tr_b16 %0, %1\n\ts_waitcnt lgkmcnt(0)" : "=&v"(r) : "v"(a) : "memory"); return r; }
DI bf16x8 pack8(const f32x4& a, const f32x4& b) { u32x4 w; w.x = pk2(a[0], a[1]); w.y = pk2(a[2], a[3]); w.z = pk2(b[0], b[1]); w.w = pk2(b[2], b[3]); return __builtin_bit_cast(bf16x8, w); }

__device__ void mlstm_chunk(unsigned char* ldsg, const bf16_t* proj0, const float* gates, float* gpre, bf16_t* hf, bf16_t* hb) {
    LAS unsigned char* L = (LAS unsigned char*)ldsg; const unsigned lbase = (unsigned)(size_t)ldsg;
    constexpr int QP = 144, VP = 112;
    constexpr int OQ = 0, OKK = OQ + 2 * 64 * QP, OV = OKK + 2 * 64 * QP, OG = OV + 2 * 64 * VP, OVW = OG + 2 * 320 * 4, OC = OVW + 2 * 64 * VP, OCH = OC + 2 * 48 * QP;
    int tid_ = threadIdx.x; asm volatile("" : "+v"(tid_));
    const int tid = tid_, lane = tid & 63, w = __builtin_amdgcn_readfirstlane(tid >> 6), i16 = lane & 15, q4 = lane >> 4, lt = w & 3, half = w >> 2;
    const int ql_t = tid >> 3, ql_s = tid & 7, vl_t = (tid & 255) >> 2, vl_s = tid & 3;
    LAS float* chg = (LAS float*)(L + OCH); LAS float* cha = chg + 128; LAS float* chm = chg + 256; LAS float* chn = chg + 384; LAS float* chd = chg + 512;
    const int vb_ = ((gridDim.x & 7) == 0) ? (int)((blockIdx.x & 7) * (gridDim.x >> 3) + (blockIdx.x >> 3)) : (int)blockIdx.x;
    for (int unit = vb_; unit < 256; unit += gridDim.x) {
        const int dvq = unit & 3, dir = (unit >> 2) & 1, h = (unit >> 3) & 7, b = unit >> 6;
        bf16_t* hout = dir ? hb : hf;
        float* gp = gpre + (size_t)unit * 128 * 320;
        __syncthreads();
        {
#pragma unroll 2
            for (int i = 0; i < 16; ++i) { const int c = w + 8 * i; const int tb = b * SEQ + (dir ? SEQ - 64 * (c + 1) : 64 * c); const int tg = tb + (dir ? 63 - lane : lane);
                const float igv = gates[(size_t)tg * 32 + dir * 8 + h], fpv = gates[(size_t)tg * 32 + 16 + dir * 8 + h];
                float bc = -__logf(1.0f + __expf(-fpv));
#pragma unroll
                for (int o = 1; o < 64; o <<= 1) { const float t = __shfl_up(bc, o); if (lane >= o) bc += t; }
                const float gt = __shfl(bc, 63); float amax = gt - bc + igv;
#pragma unroll
                for (int o = 32; o >= 1; o >>= 1) amax = fmaxf(amax, __shfl_xor(amax, o));
                const float dd = igv - bc; float pm = dd;
#pragma unroll
                for (int o = 1; o < 64; o <<= 1) { const float t = __shfl_up(pm, o); if (lane >= o) pm = fmaxf(pm, t); }
                float* o_ = gp + (size_t)c * 320 + lane; o_[0] = bc; o_[64] = pm; o_[256] = dd;
                if (lane == 0) { chg[c] = gt; cha[c] = amax; } }
            __syncthreads();
            if (w == 0) {
                const float g0 = chg[lane], g1 = chg[64 + lane], a0 = cha[lane], a1 = cha[64 + lane];
                float m = 0.f, mp0 = 0.f, mp1 = 0.f, mn0 = 0.f, mn1 = 0.f, dc0 = 0.f, dc1 = 0.f;
                for (int c = 0; c < 64; ++c) { const float g = __shfl(g0, c), a = __shfl(a0, c); const float mn = fmaxf(g + m, a), dc = __expf(g + m - mn);
                    if (lane == c) { mp0 = m; mn0 = mn; dc0 = dc; } m = mn; }
                for (int c = 0; c < 64; ++c) { const float g = __shfl(g1, c), a = __shfl(a1, c); const float mn = fmaxf(g + m, a), dc = __expf(g + m - mn);
                    if (lane == c) { mp1 = m; mn1 = mn; dc1 = dc; } m = mn; }
                chm[lane] = mp0; chm[64 + lane] = mp1; chn[lane] = mn0; chn[64 + lane] = mn1; chd[lane] = dc0; chd[64 + lane] = dc1;
            }
            __syncthreads();
#pragma unroll 4
            for (int i = 0; i < 16; ++i) { const int c = w + 8 * i; const float mprev = chm[c], mnew = chn[c], gt = chg[c];
                float* o_ = gp + (size_t)c * 320 + lane; const float bc = o_[0], pm = o_[64], dd = o_[256];
                const float il = bc + mprev, mj = fmaxf(il, bc + pm);
                o_[0] = __expf(bc - mj); o_[64] = __expf(il - mj); o_[128] = __expf(-mj); o_[192] = __expf(gt + dd - mnew); o_[256] = __expf(dd); }
            asm volatile("s_waitcnt vmcnt(0)" ::: "memory");
            __syncthreads();
        }
        u32x4 rqA, rkA, rvA = {0u, 0u, 0u, 0u}, rqB, rkB, rvB = {0u, 0u, 0u, 0u}; float rgA = 0.f, raA = 0.f, rfA = 0.f, rgB = 0.f, raB = 0.f, rfB = 0.f;
        const long dstep = dir ? -(long)64 * 3072 : (long)64 * 3072;
        const bf16_t* qptr = proj0 + (size_t)(b * SEQ + (dir ? SEQ - 1 - ql_t : ql_t)) * 3072 + h * 64 + ql_s * 8;
        const bf16_t* vptr = proj0 + (size_t)(b * SEQ + (dir ? SEQ - 1 - vl_t : vl_t)) * 3072 + 1024 + h * 128 + dvq * 32 + vl_s * 8;
        const float* gptr = gp + tid; const float* aptr = gp + 192 + (tid < 256 ? vl_t : tid - 256);
#define CH_LOAD(ci, rq, rk, rv, rg, ra, rf) do { rq = *(const u32x4*)qptr; rk = *(const u32x4*)(qptr + 512); qptr += dstep; \
        if (tid < 256) { rv = *(const u32x4*)vptr; vptr += dstep; } \
        if (tid < 320) { ra = __builtin_nontemporal_load(aptr); rf = __builtin_nontemporal_load(aptr + 64); rg = __builtin_nontemporal_load(gptr); aptr += 320; gptr += 320; } } while (0)
#define CH_STORE(bb, rq, rk, rv, rg, ra, rf) do { *(LAS u32x4*)(L + OQ + (bb) * 64 * QP + ql_t * QP + ql_s * 16) = rq; *(LAS u32x4*)(L + OKK + (bb) * 64 * QP + ql_t * QP + ql_s * 16) = rk; \
        if (tid < 256) { u32x4 o_, f_; const float v0_ = bflo(rv.x), v1_ = bfhi(rv.x), v2_ = bflo(rv.y), v3_ = bfhi(rv.y), v4_ = bflo(rv.z), v5_ = bfhi(rv.z), v6_ = bflo(rv.w), v7_ = bfhi(rv.w); \
            o_.x = pk2(v0_ * ra, v1_ * ra); o_.y = pk2(v2_ * ra, v3_ * ra); o_.z = pk2(v4_ * ra, v5_ * ra); o_.w = pk2(v6_ * ra, v7_ * ra); \
            f_.x = pk2(v0_ * rf, v1_ * rf); f_.y = pk2(v2_ * rf, v3_ * rf); f_.z = pk2(v4_ * rf, v5_ * rf); f_.w = pk2(v6_ * rf, v7_ * rf); \
            *(LAS u32x4*)(L + OVW + (bb) * 64 * VP + vl_t * VP + vl_s * 16) = o_; *(LAS u32x4*)(L + OV + (bb) * 64 * VP + vl_t * VP + vl_s * 16) = f_; } \
        else if (tid < 320) { LAS unsigned char* r_ = L + OVW + (bb) * 64 * VP + (tid - 256) * VP + 64; *(LAS u32x4*)r_ = u32x4{pk2(ra, 0.f), 0u, 0u, 0u}; *(LAS u32x4*)(r_ + 16) = u32x4{0u, 0u, 0u, 0u}; \
            LAS unsigned char* q_ = L + OV + (bb) * 64 * VP + (tid - 256) * VP + 64; *(LAS u32x4*)q_ = u32x4{pk2(rf, 0.f), 0u, 0u, 0u}; *(LAS u32x4*)(q_ + 16) = u32x4{0u, 0u, 0u, 0u}; } \
        if (tid < 320) *(LAS float*)(L + OG + (bb) * 1280 + tid * 4) = rg; } while (0)
        CH_LOAD(0, rqA, rkA, rvA, rgA, raA, rfA); CH_STORE(0, rqA, rkA, rvA, rgA, raA, rfA);
        CH_LOAD(1, rqA, rkA, rvA, rgA, raA, rfA);
        for (int i = tid; i < 2 * 432; i += NTHREADS) *(LAS u32x4*)(L + OC + i * 16) = u32x4{0u, 0u, 0u, 0u};
        f32x4 Cacc[2]; Cacc[0] = f32x4{0.f, 0.f, 0.f, 0.f}; Cacc[1] = f32x4{0.f, 0.f, 0.f, 0.f};
        const long ostep = dir ? -(long)64 * D : (long)64 * D;
        bf16_t* optr = hout + (size_t)(b * SEQ + (dir ? SEQ - 1 - (16 * lt + i16) : 16 * lt + i16)) * D + h * 128 + dvq * 32 + 16 * half + 4 * q4;
        __syncthreads();
        for (int ci = 0; ci < 128; ++ci) {
            const int buf = ci & 1;
            if (ci + 2 < 128) CH_LOAD(ci + 2, rqB, rkB, rvB, rgB, raB, rfB);
            const LAS float* gq = (const LAS float*)(L + OG + buf * 1280);
            const int lq = 16 * lt + i16;
            const float e_l = gq[lq], iw_l = gq[64 + lq], emj_l = gq[128 + lq], decay = chd[ci];
            bf16x8 qf[2];
#pragma unroll
            for (int kk = 0; kk < 2; ++kk) qf[kk] = *(const LAS bf16x8*)(L + OQ + buf * 64 * QP + lq * QP + (32 * kk + 8 * q4) * 2);
            f32x4 ai0 = {0.f, 0.f, 0.f, 0.f}, ai1 = ai0, ax0 = ai0, ax1 = ai0;
            const LAS unsigned char* Cr = L + OC + buf * 48 * QP;
#pragma unroll
            for (int kk = 0; kk < 2; ++kk) { const bf16x8 c0 = *(const LAS bf16x8*)(Cr + (16 * half + i16) * QP + (32 * kk + 8 * q4) * 2), c1 = *(const LAS bf16x8*)(Cr + (32 + i16) * QP + (32 * kk + 8 * q4) * 2);
                ax0 = __builtin_amdgcn_mfma_f32_16x16x32_bf16(c0, qf[kk], ax0, 0, 0, 0); ax1 = __builtin_amdgcn_mfma_f32_16x16x32_bf16(c1, qf[kk], ax1, 0, 0, 0); }
            Cacc[0] *= decay; Cacc[1] *= decay;
            { const unsigned vwl = lbase + OVW + buf * 64 * VP + (i16 >> 2) * VP + (i16 & 3) * 8, kl = lbase + OKK + buf * 64 * QP + (i16 >> 2) * QP + (i16 & 3) * 8;
              const unsigned k0 = kl + (4 * q4) * QP + 32 * lt, k1 = k0 + 32 * QP, w0 = vwl + (4 * q4) * VP, w1 = w0 + 32 * VP; bf16x8 kb0, kb1, x00, x01, x10, x11, dmy0, dmy1;
              tr_read8(k0, k0 + 16 * QP, k1, k1 + 16 * QP, w0 + 32 * half, w0 + 16 * VP + 32 * half, w0 + 64, w0 + 16 * VP + 64, kb0, kb1, x00, x01);
              tr_read8(w1 + 32 * half, w1 + 16 * VP + 32 * half, w1 + 64, w1 + 16 * VP + 64, w1 + 32 * half, w1 + 16 * VP + 32 * half, w1 + 64, w1 + 16 * VP + 64, x10, x11, dmy0, dmy1);
              Cacc[0] = __builtin_amdgcn_mfma_f32_16x16x32_bf16(x00, kb0, Cacc[0], 0, 0, 0); Cacc[1] = __builtin_amdgcn_mfma_f32_16x16x32_bf16(x01, kb0, Cacc[1], 0, 0, 0);
              Cacc[0] = __builtin_amdgcn_mfma_f32_16x16x32_bf16(x10, kb1, Cacc[0], 0, 0, 0); Cacc[1] = __builtin_amdgcn_mfma_f32_16x16x32_bf16(x11, kb1, Cacc[1], 0, 0, 0); }
            { LAS unsigned char* Cw = L + OC + (buf ^ 1) * 48 * QP;
#pragma unroll
              for (int j = 0; j < 4; ++j) { *(LAS bf16_t*)(Cw + (16 * half + 4 * q4 + j) * QP + (16 * lt + i16) * 2) = (bf16_t)(pk2(Cacc[0][j], 0.f) & 0xffffu);
                  if (half == 0) *(LAS bf16_t*)(Cw + (32 + 4 * q4 + j) * QP + (16 * lt + i16) * 2) = (bf16_t)(pk2(Cacc[1][j], 0.f) & 0xffffu); } }
            f32x4 st[4];
#pragma unroll
            for (int t = 0; t < 4; ++t) { st[t] = f32x4{0.f, 0.f, 0.f, 0.f};
#pragma unroll
                for (int kk = 0; kk < 2; ++kk) { const bf16x8 kf = *(const LAS bf16x8*)(L + OKK + buf * 64 * QP + (16 * t + i16) * QP + (32 * kk + 8 * q4) * 2);
                    st[t] = __builtin_amdgcn_mfma_f32_16x16x32_bf16(kf, qf[kk], st[t], 0, 0, 0); } }
#pragma unroll
            for (int t = 0; t < 4; ++t)
#pragma unroll
                for (int j = 0; j < 4; ++j) { const int s = 16 * t + 4 * q4 + j; st[t][j] = (s <= lq) ? st[t][j] : 0.f; }
            const unsigned vl = lbase + OV + buf * 64 * VP + (i16 >> 2) * VP + (i16 & 3) * 8;
            { const bf16x8 pf0 = pack8(st[0], st[1]), pf1 = pack8(st[2], st[3]); const unsigned a0 = vl + (4 * q4) * VP, a1 = a0 + 32 * VP; bf16x8 v00, v01, v10, v11;
              tr_read8(a0 + 32 * half, a0 + 16 * VP + 32 * half, a0 + 64, a0 + 16 * VP + 64, a1 + 32 * half, a1 + 16 * VP + 32 * half, a1 + 64, a1 + 16 * VP + 64, v00, v01, v10, v11);
              ai0 = __builtin_amdgcn_mfma_f32_16x16x32_bf16(v00, pf0, ai0, 0, 0, 0); ai1 = __builtin_amdgcn_mfma_f32_16x16x32_bf16(v01, pf0, ai1, 0, 0, 0);
              ai0 = __builtin_amdgcn_mfma_f32_16x16x32_bf16(v10, pf1, ai0, 0, 0, 0); ai1 = __builtin_amdgcn_mfma_f32_16x16x32_bf16(v11, pf1, ai1, 0, 0, 0); }
            { const f32x4 num = ai0 * e_l + ax0 * iw_l; float den = ai1[0] * e_l + ax1[0] * iw_l; den = __shfl(den, i16);
              const float inv = 1.0f / fmaxf(fabsf(den), emj_l);
              u32x2 o; o.x = pk2(num[0] * inv, num[1] * inv); o.y = pk2(num[2] * inv, num[3] * inv);
              *(u32x2*)optr = o; optr += ostep; }
            if (ci + 1 < 128) CH_STORE(buf ^ 1, rqA, rkA, rvA, rgA, raA, rfA);
            rqA = rqB; rkA = rkB; rvA = rvB; rgA = rgB; raA = raB; rfA = rfB;
            __syncthreads();
        }
    }
#undef CH_LOAD
#undef CH_STORE
}
__device__ void mlstm_combine(bf16_t* hf, const bf16_t* hb, const bf16_t* proj0, const float* head_norm) {
    int tid_ = threadIdx.x; asm volatile("" : "+v"(tid_));
    const int lane = tid_ & 63, wv = tid_ >> 6, col = lane * 16;
    f32x4 hn[4];
#pragma unroll
    for (int j = 0; j < 4; ++j) hn[j] = *(const f32x4*)(head_norm + col + 4 * j);
    for (int tok0 = (blockIdx.x * 8 + wv) * 4; tok0 < T; tok0 += gridDim.x * 32) { u32x4 a[4][2], b[4][2], o[4][2];
#pragma unroll
        for (int t = 0; t < 4; ++t)
#pragma unroll
            for (int k = 0; k < 2; ++k) { const size_t off = (size_t)(tok0 + t) * D + col + 8 * k; a[t][k] = *(const u32x4*)(hf + off); b[t][k] = *(const u32x4*)(hb + off);
                o[t][k] = *(const u32x4*)(proj0 + (size_t)(tok0 + t) * 3072 + 2048 + col + 8 * k); }
#pragma unroll
        for (int t = 0; t < 4; ++t) { float h[16], og[16];
#pragma unroll
            for (int k = 0; k < 2; ++k)
#pragma unroll
                for (int j = 0; j < 4; ++j) { h[8 * k + 2 * j] = bflo(a[t][k][j]) + bflo(b[t][k][j]); h[8 * k + 2 * j + 1] = bfhi(a[t][k][j]) + bfhi(b[t][k][j]);
                    og[8 * k + 2 * j] = bflo(o[t][k][j]); og[8 * k + 2 * j + 1] = bfhi(o[t][k][j]); }
            float sq = 0.f;
#pragma unroll
            for (int j = 0; j < 16; ++j) sq += h[j] * h[j];
            sq += __shfl_xor(sq, 1); sq += __shfl_xor(sq, 2); sq += __shfl_xor(sq, 4);
            const float rs = rsqrtf(sq * (1.0f / 128.0f) + 1e-6f);
            float r[16];
#pragma unroll
            for (int j = 0; j < 16; ++j) r[j] = sigmoidf_(og[j]) * h[j] * rs * hn[j >> 2][j & 3];
            u32x4 w0, w1;
#pragma unroll
            for (int j = 0; j < 4; ++j) { w0[j] = pk2(r[2 * j], r[2 * j + 1]); w1[j] = pk2(r[8 + 2 * j], r[9 + 2 * j]); }
            *(u32x4*)(hf + (size_t)(tok0 + t) * D + col) = w0; *(u32x4*)(hf + (size_t)(tok0 + t) * D + col + 8) = w1; }
    }
}

__device__ void attn_phase(unsigned char* ldsg, const bf16_t* proj1, bf16_t* og0, bf16_t* og1, bf16_t* og2, float* lse) {
    LAS unsigned char* ldsl = (LAS unsigned char*)ldsg;
    const unsigned lds_base = (unsigned)(size_t)ldsg;
    int tid_ = threadIdx.x; asm volatile("" : "+v"(tid_));
    const int tid = tid_, lane = tid & 63, w = __builtin_amdgcn_readfirstlane(tid >> 6), i16 = lane & 15, q4 = lane >> 4;
    const float scale = 0.08838834764831845f;
    const int vb_ = ((gridDim.x & 7) == 0) ? (int)((blockIdx.x & 7) * (gridDim.x >> 3) + (blockIdx.x >> 3)) : (int)blockIdx.x;
    for (int uid = vb_; uid < 1536; uid += gridDim.x) {
        const int g = uid >> 9, rem = uid & 511, head = rem >> 6, jj = rem & 63;
        const int dsh = 2 * g, dil = 1 << dsh, U = SEQ >> dsh, nblk = U >> 7;
        const int r = jj / nblk, blk = jj % nblk, u0 = blk * 128;
        const bf16_t* qb = proj1 + g * 3072 + head * 128; const bf16_t* kb = qb + 1024; const bf16_t* vb = qb + 2048;
        {   u32x4 kr[8], vr[8];
#pragma unroll
            for (int i = 0; i < 8; ++i) { const int c = tid + 512 * i, kk = c >> 4, seg = c & 15, uk = u0 - 64 + kk; const bool ok = uk >= 0 && uk < U;
                const size_t off = (size_t)((ok ? uk : 0) * dil + r) * 9216 + seg * 8;
                kr[i] = *(const u32x4*)(kb + off); vr[i] = *(const u32x4*)(vb + off);
                if (!ok) { kr[i] = u32x4{0u, 0u, 0u, 0u}; vr[i] = u32x4{0u, 0u, 0u, 0u}; } }
#pragma unroll
            for (int i = 0; i < 8; ++i) { const int c = tid + 512 * i, kk = c >> 4, seg = c & 15;
                *(LAS u32x4*)(ldsl + kk * 288 + seg * 16) = kr[i]; *(LAS u32x4*)(ldsl + 73728 + kk * 288 + seg * 16) = vr[i]; } }
        __syncthreads();
        const int uq = u0 + 16 * w + i16; const size_t tokl = (size_t)uq * dil + r;
        bf16x8 qf[4];
#pragma unroll
        for (int kk = 0; kk < 4; ++kk) qf[kk] = *(const bf16x8*)(qb + tokl * 9216 + 32 * kk + 8 * q4);
        f32x4 s[9];
#pragma unroll
        for (int kt = 0; kt < 9; ++kt) { s[kt] = f32x4{0.f, 0.f, 0.f, 0.f};
#pragma unroll
            for (int kk = 0; kk < 4; ++kk) { const bf16x8 kf = *(const LAS bf16x8*)(ldsl + (16 * (w + kt) + i16) * 288 + (32 * kk + 8 * q4) * 2);
                s[kt] = __builtin_amdgcn_mfma_f32_16x16x32_bf16(kf, qf[kk], s[kt], 0, 0, 0); } }
        float mx = -1e30f;
#pragma unroll
        for (int kt = 0; kt < 9; ++kt)
#pragma unroll
            for (int j = 0; j < 4; ++j) { const int dl = 16 * kt - 64 + 4 * q4 + j - i16, uk = uq + dl; const bool ok = dl >= -64 && dl <= 64 && uk >= 0 && uk < U;
                const float v = ok ? s[kt][j] * scale : -1e30f; s[kt][j] = v; mx = fmaxf(mx, v); }
        mx = fmaxf(mx, __shfl_xor(mx, 16)); mx = fmaxf(mx, __shfl_xor(mx, 32));
        float l = 0.f;
#pragma unroll
        for (int kt = 0; kt < 9; ++kt)
#pragma unroll
            for (int j = 0; j < 4; ++j) { const float p = __expf(s[kt][j] - mx); s[kt][j] = p; l += p; }
        l += __shfl_xor(l, 16); l += __shfl_xor(l, 32);
        f32x4 o[8];
#pragma unroll
        for (int nt = 0; nt < 8; ++nt) o[nt] = f32x4{0.f, 0.f, 0.f, 0.f};
        const unsigned vlane = lds_base + 73728u + (unsigned)((i16 >> 2) * 288 + (i16 & 3) * 8);
#pragma unroll
        for (int s2 = 0; s2 < 4; ++s2) {
            u32x4 pw; pw.x = pk2(s[2 * s2][0], s[2 * s2][1]); pw.y = pk2(s[2 * s2][2], s[2 * s2][3]); pw.z = pk2(s[2 * s2 + 1][0], s[2 * s2 + 1][1]); pw.w = pk2(s[2 * s2 + 1][2], s[2 * s2 + 1][3]);
            const bf16x8 pf = __builtin_bit_cast(bf16x8, pw);
            const unsigned a0 = vlane + (unsigned)((16 * (w + 2 * s2) + 4 * q4) * 288);
#pragma unroll
            for (int n4 = 0; n4 < 8; n4 += 4) { bf16x8 v0, v1, v2, v3; const unsigned a1 = a0 + 32 * n4, a2 = a1 + 16 * 288;
                tr_read8(a1, a2, a1 + 32, a2 + 32, a1 + 64, a2 + 64, a1 + 96, a2 + 96, v0, v1, v2, v3);
                o[n4] = __builtin_amdgcn_mfma_f32_16x16x32_bf16(v0, pf, o[n4], 0, 0, 0); o[n4 + 1] = __builtin_amdgcn_mfma_f32_16x16x32_bf16(v1, pf, o[n4 + 1], 0, 0, 0);
                o[n4 + 2] = __builtin_amdgcn_mfma_f32_16x16x32_bf16(v2, pf, o[n4 + 2], 0, 0, 0); o[n4 + 3] = __builtin_amdgcn_mfma_f32_16x16x32_bf16(v3, pf, o[n4 + 3], 0, 0, 0); }
        }
        {   u32x2 pw; pw.x = pk2(s[8][0], s[8][1]); pw.y = pk2(s[8][2], s[8][3]); const s16x4 pf = __builtin_bit_cast(s16x4, pw);
            const unsigned a0 = vlane + (unsigned)((16 * (w + 8) + 4 * q4) * 288);
#pragma unroll
            for (int nt = 0; nt < 8; ++nt) { const s16x4 vf = tr_read1(a0 + 32 * nt); o[nt] = __builtin_amdgcn_mfma_f32_16x16x16bf16_1k(vf, pf, o[nt], 0, 0, 0); } }
        const float inv = 1.0f / l; const size_t orow = tokl * D + head * 128; bf16_t* og = g == 0 ? og0 : (g == 1 ? og1 : og2);
#pragma unroll
        for (int nt = 0; nt < 8; ++nt) { const f32x4 v = o[nt] * inv; u32x2 wv; wv.x = pk2(v[0], v[1]); wv.y = pk2(v[2], v[3]); *(u32x2*)(og + orow + 16 * nt + 4 * q4) = wv; }
        if (q4 == 0) lse[((size_t)g * SEQ + tokl) * 8 + head] = mx + __logf(l);
        __syncthreads();
    }
}
__device__ void attn_merge(const bf16_t* og0, const bf16_t* og1, const bf16_t* og2, const float* lse, bf16_t* obuf) {
    int tid_ = threadIdx.x; asm volatile("" : "+v"(tid_));
    const int lane = tid_ & 63, wv = tid_ >> 6, col = lane * 16, head = lane >> 3;
    for (int tok0 = (blockIdx.x * 8 + wv) * 2; tok0 < SEQ; tok0 += gridDim.x * 16) { u32x4 a[2][3][2]; float ls[2][3];
#pragma unroll
        for (int t = 0; t < 2; ++t)
#pragma unroll
            for (int g = 0; g < 3; ++g) { const bf16_t* og = g == 0 ? og0 : (g == 1 ? og1 : og2); const int tok = tok0 + t;
                ls[t][g] = lse[((size_t)g * SEQ + tok) * 8 + head]; a[t][g][0] = *(const u32x4*)(og + (size_t)tok * D + col); a[t][g][1] = *(const u32x4*)(og + (size_t)tok * D + col + 8); }
#pragma unroll
        for (int t = 0; t < 2; ++t) { const float M = fmaxf(ls[t][0], fmaxf(ls[t][1], ls[t][2]));
            float w0 = __expf(ls[t][0] - M), w1 = __expf(ls[t][1] - M), w2 = __expf(ls[t][2] - M); const float inv = 1.0f / (w0 + w1 + w2); w0 *= inv; w1 *= inv; w2 *= inv;
            float acc[16];
#pragma unroll
            for (int j = 0; j < 16; ++j) acc[j] = 0.f;
#pragma unroll
            for (int g = 0; g < 3; ++g) { const float wg = g == 0 ? w0 : (g == 1 ? w1 : w2);
#pragma unroll
                for (int j = 0; j < 4; ++j) { acc[2 * j] += wg * bflo(a[t][g][0][j]); acc[2 * j + 1] += wg * bfhi(a[t][g][0][j]); acc[8 + 2 * j] += wg * bflo(a[t][g][1][j]); acc[9 + 2 * j] += wg * bfhi(a[t][g][1][j]); } }
            u32x4 w0v, w1v;
#pragma unroll
            for (int j = 0; j < 4; ++j) { w0v[j] = pk2(acc[2 * j], acc[2 * j + 1]); w1v[j] = pk2(acc[8 + 2 * j], acc[9 + 2 * j]); }
            *(u32x4*)(obuf + (size_t)(tok0 + t) * D + col) = w0v; *(u32x4*)(obuf + (size_t)(tok0 + t) * D + col + 8) = w1v; }
    }
}
__device__ void final_norm(float* out, const bf16_t* xin, const float* ss, const float* fn) {
    int tid_ = threadIdx.x; asm volatile("" : "+v"(tid_));
    const int lane = tid_ & 63, wv = tid_ >> 6;
    f32x4 f[2][2];
#pragma unroll
    for (int i = 0; i < 2; ++i) { f[i][0] = *(const f32x4*)(fn + (i * 64 + lane) * 8); f[i][1] = *(const f32x4*)(fn + (i * 64 + lane) * 8 + 4); }
    for (int row0 = (blockIdx.x * 8 + wv) * 8; row0 < T; row0 += gridDim.x * 64) { u32x4 v[8][2]; float sp[8];
#pragma unroll
        for (int r = 0; r < 8; ++r) { sp[r] = ss[(size_t)(row0 + r) * 16 + (lane & 15)];
#pragma unroll
            for (int i = 0; i < 2; ++i) v[r][i] = *(const u32x4*)(xin + (size_t)(row0 + r) * D + (i * 64 + lane) * 8); }
#pragma unroll
        for (int r = 0; r < 8; ++r) { float s = sp[r]; s += __shfl_xor(s, 1); s += __shfl_xor(s, 2); s += __shfl_xor(s, 4); s += __shfl_xor(s, 8);
            const float rs = rsqrtf(s * (1.0f / 1024.0f) + 1e-6f);
#pragma unroll
            for (int i = 0; i < 2; ++i) { const u32x4 w = v[r][i]; float* o = out + (size_t)(row0 + r) * D + (i * 64 + lane) * 8;
                *(f32x4*)o = f32x4{bflo(w.x), bfhi(w.x), bflo(w.y), bfhi(w.y)} * rs * f[i][0];
                *(f32x4*)(o + 4) = f32x4{bflo(w.z), bfhi(w.z), bflo(w.w), bfhi(w.w)} * rs * f[i][1]; } } }
}

#ifndef PHMASK
#define PHMASK 0xFFFFFFFFu
#endif
#ifndef REPMASK
#define REPMASK 0u
#endif
#define EN(k) (((PHMASK) >> (k)) & 1u)
__global__ void __launch_bounds__(NTHREADS, 2) fwd_kernel(Params P) {
    extern __shared__ __attribute__((aligned(16))) unsigned char lds[];
    cg::grid_group grid = cg::this_grid();
    LAS unsigned char* ldsl = (LAS unsigned char*)lds;
    const int G = gridDim.x, bid = blockIdx.x;
    const int ph_lo = P.ph_lo, ph_hi = P.ph_hi;
    if (threadIdx.x < 4) ((LAS unsigned*)(ldsl + LDS_MAIN))[threadIdx.x] = 0u;
    __syncthreads();
    XcdBarrier xbar; xbar.bar = (unsigned*)(P.ws + OFF_BAR); xbar.x = 0; xbar.st = (volatile LAS unsigned*)(ldsl + LDS_MAIN);
    if (ph_hi - ph_lo > 1) xbar = xcd_barrier_post((unsigned*)(P.ws + OFF_BAR), (volatile LAS unsigned*)(ldsl + LDS_MAIN));
    if (ph_hi > 1000) grid.sync();
    for (int ph = ph_lo; ph < ph_hi; ++ph) {
        const __attribute__((address_space(4))) Params* PP = (const __attribute__((address_space(4))) Params*)__builtin_amdgcn_kernarg_segment_ptr();
        asm volatile("" : "+s"(PP));
        unsigned char* ws = PP->ws; float* const outp = PP->out;
        bf16_t* const xbA = (bf16_t*)(ws + OFF_XB); bf16_t* const xbB = (bf16_t*)outp; bf16_t* const obuf = (bf16_t*)outp + (size_t)T * D;
        int phx = ph; asm volatile("" : "+s"(phx));
        bf16_t* xb = (phx >= 8 && phx <= 18) ? xbB : xbA;
        float* ss0 = (float*)(ws + OFF_SS0); float* ss1 = (float*)(ws + OFF_SS1);
#define PIN(i) (PP->in[i])
        const int nrep = ((REPMASK >> ph) & 1u) ? 2 : 1;
        for (int rep = 0; rep < nrep; ++rep) {
        if (rep) __syncthreads();
        if (EN(0) && ph == 0) {
            LAS float* tile = (LAS float*)ldsl;
            prep_weight(tile, PIN(4), nullptr, PIN(3), (bf16_t*)(ws + W_IN0), 1024, 3104, 3328, 1);
            prep_weight(tile, PIN(7), nullptr, nullptr, (bf16_t*)(ws + W_OUT0), 1024, 1024, 1024, 0);
            prep_weight(tile, PIN(8), nullptr, PIN(3) + 1024, (bf16_t*)(ws + W_IN1), 1024, 9216, 9216, 2);
            prep_weight(tile, PIN(9), nullptr, nullptr, (bf16_t*)(ws + W_OUT1), 1024, 1024, 1024, 0);
            for (int l = 0; l < 2; ++l) {
                prep_weight(tile, PIN(11) + (size_t)l * 1024 * FF, PIN(12) + (size_t)l * 1024 * FF, PIN(10) + l * 1024, (bf16_t*)(ws + (l ? W_GU1 : W_GU0)), 1024, FF, 2 * FF, 3);
                prep_weight(tile, PIN(13) + (size_t)l * FF * 1024, nullptr, nullptr, (bf16_t*)(ws + (l ? W_DN1 : W_DN0)), FF, 1024, 1024, 0);
                prep_weight(tile, PIN(15) + (size_t)l * 1024 * 1024, nullptr, PIN(14) + l * 1024, (bf16_t*)(ws + (l ? W_PG1 : W_PG0)), 1024, 1024, 1024, 0);
                prep_weight(tile, PIN(16) + (size_t)l * 256 * 1024, nullptr, nullptr, (bf16_t*)(ws + (l ? W_PP1 : W_PP0)), 256, 1024, 1024, 0);
            }
            prep_misc(PIN(0), PIN(1), (const int*)PIN(2), ws, PP->inv_freq);
        } else if (EN(1) && ph == 1) {
            pg8::Gemm g{xb, (const bf16_t*)(ws + W_IN0), T, 3328, 1024}; pg8::StaticOrder S; S.init(T, 3328, G, bid);
            EpiProj0 E{(bf16_t*)(ws + OFF_PROJ0), (float*)(ws + OFF_GATES), PIN(5), ss0};
            pg8::gemm_phase<EpiProj0, pg8::StaticOrder>(ldsl, g, S, E);
        } else if (EN(2) && ph == 2) {
            mlstm_chunk(lds, (const bf16_t*)(ws + OFF_PROJ0), (const float*)(ws + OFF_GATES), (float*)(ws + OFF_GP), (bf16_t*)(ws + OFF_HG), xb);
        } else if (EN(3) && ph == 3) {
            mlstm_combine((bf16_t*)(ws + OFF_HG), xb, (const bf16_t*)(ws + OFF_PROJ0), PIN(6));
        } else if (EN(4) && (ph == 4 || ph == 15 || ph == 6 || ph == 17)) {
            int phl = ph; asm volatile("" : "+s"(phl));
            const int l = phl > 10; const bool down = (phl == 6 || phl == 17);
            float* ssw = (phl == 4 || phl == 17) ? ss1 : ss0;
            const bf16_t* A = down ? (const bf16_t*)(ws + OFF_HID) : (l ? (const bf16_t*)obuf : (const bf16_t*)(ws + OFF_HG));
            const bf16_t* Bt = down ? (const bf16_t*)(ws + (l ? W_DN1 : W_DN0)) : (const bf16_t*)(ws + (l ? W_OUT1 : W_OUT0));
            pg8::Gemm g{A, Bt, T, 1024, down ? FF : 1024}; pg8::StaticOrder S; S.init(T, 1024, G, bid);
            if (phl == 4) { EpiRes<true> E{(const void*)PIN(0), xb, ssw}; pg8::gemm_phase<EpiRes<true>, pg8::StaticOrder>(ldsl, g, S, E); }
            else { EpiRes<false> E{(const void*)xb, xb, ssw}; pg8::gemm_phase<EpiRes<false>, pg8::StaticOrder>(ldsl, g, S, E); }
            if (EN(11) && down) {
                pg8::Gemm g2{(const bf16_t*)(ws + OFF_PB) + (size_t)l * T * 256, (const bf16_t*)(ws + (l ? W_PP1 : W_PP0)), T, 1024, 256};
                EpiPlain E2{(bf16_t*)(ws + OFF_PPB), 1024};
                pg8::gemm_phase<EpiPlain, pg8::StaticOrder>(ldsl, g2, S, E2);
            }
        } else if (EN(5) && (ph == 5 || ph == 16)) {
            int phl = ph; asm volatile("" : "+s"(phl));
            const int l = phl > 10;
            pg8::Gemm g{xb, (const bf16_t*)(ws + (l ? W_GU1 : W_GU0)), T, 2 * FF, 1024}; pg8::StaticOrder S; S.init(T, 2 * FF, G, bid);
            EpiFfnUp E{(bf16_t*)(ws + OFF_HID), l ? ss0 : ss1};
            pg8::gemm_phase<EpiFfnUp, pg8::StaticOrder>(ldsl, g, S, E);
        } else if (EN(6) && (ph == 7 || ph == 18)) {
            int phl = ph; asm volatile("" : "+s"(phl));
            const int l = phl > 10;
            pg8::Gemm g{xb, (const bf16_t*)(ws + (l ? W_PG1 : W_PG0)), T, 1024, 1024}; pg8::StaticOrder S; S.init(T, 1024, G, bid);
            EpiPle E{xb, l ? xbA : xbB, (const bf16_t*)(ws + OFF_PPB), l ? ss1 : ss0, l ? ss0 : ss1};
            pg8::gemm_phase<EpiPle, pg8::StaticOrder>(ldsl, g, S, E);
        } else if (ph >= 8 && ph <= 14) {
            int phl = ph; asm volatile("" : "+s"(phl));
            const int j = phl - 8;
            bf16_t* const pA0 = (bf16_t*)(ws + OFF_XB), * const pA1 = (bf16_t*)(ws + OFF_XB + 16 * MiB), * const pA2 = (bf16_t*)(ws + OFF_XB + 32 * MiB);
            bf16_t* const pB0 = (bf16_t*)(ws + OFF_PB), * const pB1 = (bf16_t*)(ws + 468 * MiB), * const pB2 = (bf16_t*)(ws + 484 * MiB);
            float* const lA = (float*)(ws + OFF_LSE), * const lB = (float*)(ws + OFF_LSE + MiB);
            const int mb = (j == 2) ? 0 : (j == 3) ? 1 : (j == 5) ? 2 : (j == 6) ? 3 : -1;
            const int ab = (j == 1) ? 0 : (j == 2) ? 1 : (j == 4) ? 2 : (j == 5) ? 3 : -1;
            if (EN(8) && mb >= 0) { const bool sB = mb & 1; attn_merge(sB ? pB0 : pA0, sB ? pB1 : pA1, sB ? pB2 : pA2, sB ? lB : lA, obuf + (size_t)mb * SEQ * D); }
            if (EN(7) && ab >= 0) { const bool sB = ab & 1; __syncthreads();
                attn_phase(lds, (const bf16_t*)(ws + OFF_PROJ1) + (size_t)(ab & 1) * SEQ * 9216, sB ? pB0 : pA0, sB ? pB1 : pA1, sB ? pB2 : pA2, sB ? lB : lA); }
            if (EN(9) && (j == 0 || j == 3)) { const int hf_ = j ? 1 : 0;
                __syncthreads();
                pg8::Gemm g{xb + (size_t)hf_ * 2 * SEQ * D, (const bf16_t*)(ws + W_IN1), 2 * SEQ, 9216, 1024}; pg8::StaticOrder S; S.init(2 * SEQ, 9216, G, bid);
                EpiProj1 E{(bf16_t*)(ws + OFF_PROJ1), ss1, (const float*)(ws + OFF_COS), (const float*)(ws + OFF_SIN), hf_ * 2 * SEQ};
                pg8::gemm_phase<EpiProj1, pg8::StaticOrder>(ldsl, g, S, E);
            }
        } else if (EN(10) && ph == 19) {
            final_norm(outp, xbA, ss0, PIN(17));
        }
        }
        if (ph + 1 < ph_hi) xcd_barrier(xbar);
    }
}

#ifndef N_LAUNCH_MODE
#define N_LAUNCH_MODE 0
#endif
extern "C" void kernel_launch(void* const* d_in, const int* in_sizes, int n_in, void* d_out, int out_size, void* d_ws, size_t ws_size, hipStream_t stream) {
    static int grid = 0;
    if (grid == 0) {
        int dev = 0, cus = 0, per_cu = 0;
        hipGetDevice(&dev); hipDeviceGetAttribute(&cus, hipDeviceAttributeMultiprocessorCount, dev);
        if (hipFuncSetAttribute((const void*)fwd_kernel, hipFuncAttributeMaxDynamicSharedMemorySize, LDS_BYTES) != hipSuccess) { fprintf(stderr, "hipFuncSetAttribute failed\n"); grid = -1; return; }
        if (hipOccupancyMaxActiveBlocksPerMultiprocessor(&per_cu, (const void*)fwd_kernel, NTHREADS, LDS_BYTES) != hipSuccess || per_cu < 1) { fprintf(stderr, "occupancy query: %d\n", per_cu); per_cu = 1; }
        (void)hipGetLastError();
        if (per_cu > 1) per_cu = 1;
        grid = cus * per_cu;
        if (ws_size < WS_END || n_in != 18) { fprintf(stderr, "kernel_launch: ws %zu < %zu or n_in %d\n", ws_size, (size_t)WS_END, n_in); grid = -1; return; }
    }
    if (grid < 0) return;
    if (hipMemsetAsync((unsigned char*)d_ws + OFF_BAR, 0, XCD_BAR_WORDS * 4, stream) != hipSuccess) { fprintf(stderr, "memset failed\n"); return; }
    Params p{};
    for (int i = 0; i < 18; ++i) p.in[i] = (const float*)d_in[i];
    p.out = (float*)d_out; p.ws = (unsigned char*)d_ws; p.repmask = REPMASK; p.pad = 0u;
    for (int i = 0; i < 16; ++i) p.inv_freq[i] = powf(500000.0f, -(float)(2 * i) / 32.0f);
#if N_LAUNCH_MODE == 0
    p.ph_lo = 0; p.ph_hi = NPH;
    void* args[] = {&p};
    hipError_t e = hipLaunchCooperativeKernel((const void*)fwd_kernel, dim3(grid), dim3(NTHREADS), args, LDS_BYTES, stream);
    if (e != hipSuccess) fprintf(stderr, "cooperative launch failed: %s (grid %d)\n", hipGetErrorString(e), grid);
#else
    for (int ph = 0; ph < NPH; ++ph) { p.ph_lo = ph; p.ph_hi = ph + 1; hipLaunchKernelGGL(fwd_kernel, dim3(grid), dim3(NTHREADS), LDS_BYTES, stream, p); }
#endif
}
```
